# Optimizing an MI355X kernel written in HIP

```python
import math
import jax, jax.numpy as jnp
from jax import lax
import numpy as np


D_MODEL = 1024
BATCH = 8
SEQ = 2048
DEPTH = 1

N_META = 16
NORM_EPS = 1e-6

RWKV_HEADS = 16
RWKV_HEAD_DIM = 64
RWKV_WIDTH = RWKV_HEADS * RWKV_HEAD_DIM
DECAY_LORA = 64
AAA_LORA = 64
GATE_LORA = 128
RWKV_GN_EPS = 64e-5
RWKV_COLS = 3 * RWKV_WIDTH + DECAY_LORA + AAA_LORA + GATE_LORA

DIFF_HEADS = 8
DIFF_HEAD_DIM = 64
DIFF_V_DIM = 2 * DIFF_HEAD_DIM
DIFF_QK_WIDTH = DIFF_HEADS * 2 * DIFF_HEAD_DIM
DIFF_V_WIDTH = DIFF_HEADS * DIFF_V_DIM
DIFF_COLS = 2 * DIFF_QK_WIDTH + DIFF_V_WIDTH
ROPE_THETA = 500000.0
ROPE_DIM = DIFF_HEAD_DIM // 4
Q_BLOCK = 128

GATE_COLS = 2 * D_MODEL
IN_COLS = RWKV_COLS + DIFF_COLS + GATE_COLS

N_GROUPS = 4
EXPERTS_PER_GROUP = 8
N_EXPERTS = N_GROUPS * EXPERTS_PER_GROUP
TOP_K = 2
EXPERT_FF = 512
MOE_BLOCK = 128

kernel_name = 'hybrid_rwkv7_diffattn_hmoe'


def rms_norm(x, w, eps=NORM_EPS):
    xf = x.astype(jnp.float32)
    y = xf * lax.rsqrt(jnp.mean(xf * xf, axis=-1, keepdims=True) + eps)
    return (y * w.astype(jnp.float32)).astype(x.dtype)


def token_shift(p):
    return jnp.pad(p, ((0, 0), (1, 0), (0, 0)))[:, :-1]


def partial_rope(t, pos):
    half = ROPE_DIM // 2
    inv_freq = jnp.exp(-math.log(ROPE_THETA) * jnp.arange(half, dtype=jnp.float32) * 2.0 / ROPE_DIM)
    ang = pos.astype(jnp.float32)[:, None] * inv_freq[None, :]
    cos = jnp.cos(ang)[None, :, None, None, :]
    sin = jnp.sin(ang)[None, :, None, None, :]
    tf = t.astype(jnp.float32)
    x1 = tf[..., :half]
    x2 = tf[..., half:ROPE_DIM]
    out = jnp.concatenate([x1 * cos - x2 * sin, x2 * cos + x1 * sin, tf[..., ROPE_DIM:]], axis=-1)
    return out.astype(t.dtype)


def rwkv7_time_mix(p, mu, w0, w2, a0, a2, g2, k_k, k_a, r_k, ln_w, ln_b):
    bsz, length, _ = p.shape
    f32 = jnp.float32
    p = p + (token_shift(p) - p) * mu
    c0 = RWKV_WIDTH
    c1 = 2 * RWKV_WIDTH
    c2 = 3 * RWKV_WIDTH
    c3 = c2 + DECAY_LORA
    c4 = c3 + AAA_LORA
    r, k, v = p[..., :c0], p[..., c0:c1], p[..., c1:c2]
    xw, xa, xg = p[..., c2:c3], p[..., c3:c4], p[..., c4:]
    w_log = -jax.nn.softplus(-(w0 + jnp.tanh(xw) @ w2).astype(f32)) - 0.5
    decay = jnp.exp(-jnp.exp(w_log))
    a = jax.nn.sigmoid((a0 + xa @ a2).astype(f32))
    g = jax.nn.sigmoid(xg) @ g2
    heads = lambda t: t.astype(f32).reshape(bsz, length, RWKV_HEADS, RWKV_HEAD_DIM)
    kk = heads(k * k_k)
    kk = kk / jnp.maximum(jnp.sqrt(jnp.sum(kk * kk, axis=-1, keepdims=True)), 1e-12)
    k = k.astype(f32) * (1.0 + (a - 1.0) * k_a.astype(f32))
    r, k, v, a, decay = heads(r), heads(k), heads(v), heads(a), heads(decay)

    def step(state, inp):
        r_t, w_t, k_t, v_t, kk_t, a_t = inp
        sa = jnp.einsum('bhvk,bhk->bhv', state, -kk_t)
        state = (state * w_t[:, :, None, :]
                 + sa[..., None] * (kk_t * a_t)[:, :, None, :]
                 + v_t[..., None] * k_t[:, :, None, :])
        return state, jnp.einsum('bhvk,bhk->bhv', state, r_t)

    seq_first = lambda t: jnp.moveaxis(t, 1, 0)
    s0 = jnp.zeros((bsz, RWKV_HEADS, RWKV_HEAD_DIM, RWKV_HEAD_DIM), f32)
    _, y = lax.scan(step, s0, tuple(map(seq_first, (r, decay, k, v, kk, a))))
    y = jnp.moveaxis(y, 0, 1)
    mean = jnp.mean(y, axis=-1, keepdims=True)
    var = jnp.mean(jnp.square(y - mean), axis=-1, keepdims=True)
    yn = ((y - mean) * lax.rsqrt(var + RWKV_GN_EPS)).reshape(bsz, length, RWKV_WIDTH)
    yn = yn * ln_w.astype(f32) + ln_b.astype(f32)
    bonus = (jnp.sum(r * k * r_k.astype(f32), axis=-1, keepdims=True) * v).reshape(bsz, length, RWKV_WIDTH)
    return ((yn + bonus) * g.astype(f32)).astype(p.dtype)


def diff_attention(p, pos, q_norm_w, k_norm_w, lq1, lk1, lq2, lk2, subln_w, lambda_init):
    bsz, length, _ = p.shape
    f32 = jnp.float32
    q = p[..., :DIFF_QK_WIDTH].reshape(bsz, length, DIFF_HEADS, 2, DIFF_HEAD_DIM)
    k = p[..., DIFF_QK_WIDTH:2 * DIFF_QK_WIDTH].reshape(bsz, length, DIFF_HEADS, 2, DIFF_HEAD_DIM)
    v = p[..., 2 * DIFF_QK_WIDTH:].reshape(bsz, length, DIFF_HEADS, DIFF_V_DIM)
    q = partial_rope(rms_norm(q, q_norm_w), pos)
    k = partial_rope(rms_norm(k, k_norm_w), pos)
    lam = (jnp.exp(jnp.sum(lq1.astype(f32) * lk1.astype(f32)))
           - jnp.exp(jnp.sum(lq2.astype(f32) * lk2.astype(f32))) + lambda_init)
    scale = DIFF_HEAD_DIM ** -0.5
    bounds = [(0, N_META)] + [(s, min(s + Q_BLOCK, length)) for s in range(N_META, length, Q_BLOCK)]
    outs = []
    for s, e in bounds:
        qb = q[:, s:e]
        kb = k[:, :e]
        vb = v[:, :e]
        sc = jnp.einsum('bqhcd,bkhcd->bhcqk', qb, kb, preferred_element_type=f32) * scale
        mask = jnp.arange(e)[None, :] <= jnp.arange(s, e)[:, None]
        pr = jax.nn.softmax(jnp.where(mask, sc, -jnp.inf), axis=-1)
        att = pr[:, :, 0] - lam * pr[:, :, 1]
        outs.append(jnp.einsum('bhqk,bkhe->bqhe', att.astype(vb.dtype), vb))
    o = jnp.concatenate(outs, axis=1)
    o = rms_norm(o, subln_w) * (1.0 - lambda_init)
    return o.reshape(bsz, length, DIFF_V_WIDTH)


def hierarchical_moe(x, wg, bg, we, be, w_gate, w_up, w_down):
    n_tok, d = x.shape
    f32 = jnp.float32
    g_prob = jax.nn.softmax((x @ wg).astype(f32) + bg.astype(f32), axis=-1)
    g_val, g_idx = lax.top_k(g_prob, 1)
    e_logits = ((x @ we).astype(f32) + be.astype(f32)).reshape(n_tok, N_GROUPS, EXPERTS_PER_GROUP)
    e_logits = jnp.take_along_axis(e_logits, g_idx[:, :, None], axis=1)[:, 0]
    e_prob = jax.nn.softmax(e_logits, axis=-1)
    e_val, e_idx = lax.top_k(e_prob, TOP_K)
    gate = g_val * e_val / jnp.sum(e_val, axis=-1, keepdims=True)
    expert_id = g_idx * EXPERTS_PER_GROUP + e_idx
    n_assign = n_tok * TOP_K
    flat_e = expert_id.reshape(n_assign)
    flat_t = jnp.repeat(jnp.arange(n_tok, dtype=jnp.int32), TOP_K)
    flat_g = gate.reshape(n_assign)
    order = jnp.argsort(flat_e)
    se = flat_e[order]
    counts = jnp.bincount(flat_e, length=N_EXPERTS)
    padded = (counts + MOE_BLOCK - 1) // MOE_BLOCK * MOE_BLOCK
    pad_end = jnp.cumsum(padded)
    pad_start = pad_end - padded
    start = jnp.cumsum(counts) - counts
    dest = pad_start[se] + jnp.arange(n_assign) - start[se]
    n_blocks = -(-n_assign // MOE_BLOCK) + N_EXPERTS
    cap = n_blocks * MOE_BLOCK
    buf_t = jnp.full((cap,), n_tok, jnp.int32).at[dest].set(flat_t[order])
    buf_g = jnp.zeros((cap,), f32).at[dest].set(flat_g[order])
    block_e = jnp.minimum(jnp.searchsorted(pad_end, jnp.arange(n_blocks) * MOE_BLOCK, side='right'),
                          N_EXPERTS - 1)
    xp = jnp.concatenate([x, jnp.zeros((1, d), x.dtype)], axis=0)
    xb = xp[buf_t].reshape(n_blocks, MOE_BLOCK, d)

    def expert_block(args):
        xblk, e = args
        hid = jax.nn.silu(xblk @ w_gate[e]) * (xblk @ w_up[e])
        return hid @ w_down[e]

    yb = lax.map(expert_block, (xb, block_e))
    y = jnp.zeros((n_tok + 1, d), f32).at[buf_t].add(yb.reshape(cap, d).astype(f32) * buf_g[:, None])
    return y[:n_tok].astype(x.dtype)


def setup_inputs(seed: int = 0) -> dict:
    key = jax.random.key(seed)
    ks = iter(jax.random.split(key, 40))
    f32 = jnp.float32

    def nrm(shape, scale):
        return jax.random.normal(next(ks), shape, f32) * scale

    def gain(shape):
        return 1.0 + nrm(shape, 0.02)

    return {
        'x': nrm((BATCH, SEQ, D_MODEL), 1.0),
        'meta_tokens': nrm((N_META, D_MODEL), 1.0),
        'norm1_w': gain((DEPTH, D_MODEL)),
        'w_in': nrm((DEPTH, D_MODEL, IN_COLS), D_MODEL ** -0.5),
        'rwkv_mu': jax.random.uniform(next(ks), (DEPTH, RWKV_COLS), f32),
        'rwkv_w0': -1.5 + nrm((DEPTH, RWKV_WIDTH), 1.0),
        'rwkv_w2': nrm((DEPTH, DECAY_LORA, RWKV_WIDTH), 0.1 * DECAY_LORA ** -0.5),
        'rwkv_a0': nrm((DEPTH, RWKV_WIDTH), 0.5),
        'rwkv_a2': nrm((DEPTH, AAA_LORA, RWKV_WIDTH), 0.5 * AAA_LORA ** -0.5),
        'rwkv_g2': nrm((DEPTH, GATE_LORA, RWKV_WIDTH), GATE_LORA ** -0.5),
        'rwkv_k_k': 0.85 + nrm((DEPTH, RWKV_WIDTH), 0.05),
        'rwkv_k_a': 1.0 + nrm((DEPTH, RWKV_WIDTH), 0.05),
        'rwkv_r_k': nrm((DEPTH, RWKV_HEADS, RWKV_HEAD_DIM), 0.1),
        'rwkv_ln_w': gain((DEPTH, RWKV_WIDTH)),
        'rwkv_ln_b': nrm((DEPTH, RWKV_WIDTH), 0.02),
        'q_norm_w': gain((DEPTH, DIFF_HEAD_DIM)),
        'k_norm_w': gain((DEPTH, DIFF_HEAD_DIM)),
        'lambda_q1': nrm((DEPTH, DIFF_HEAD_DIM), 0.1),
        'lambda_k1': nrm((DEPTH, DIFF_HEAD_DIM), 0.1),
        'lambda_q2': nrm((DEPTH, DIFF_HEAD_DIM), 0.1),
        'lambda_k2': nrm((DEPTH, DIFF_HEAD_DIM), 0.1),
        'diff_subln_w': gain((DEPTH, DIFF_V_DIM)),
        'w_branch_rwkv': nrm((DEPTH, RWKV_WIDTH, D_MODEL), RWKV_WIDTH ** -0.5),
        'w_branch_diff': nrm((DEPTH, DIFF_V_WIDTH, D_MODEL), DIFF_V_WIDTH ** -0.5),
        'w_out': nrm((DEPTH, D_MODEL, D_MODEL), D_MODEL ** -0.5),
        'norm2_w': gain((DEPTH, D_MODEL)),
        'router_group_w': nrm((DEPTH, D_MODEL, N_GROUPS), D_MODEL ** -0.5),
        'router_group_b': nrm((DEPTH, N_GROUPS), 0.01),
        'router_expert_w': nrm((DEPTH, D_MODEL, N_EXPERTS), D_MODEL ** -0.5),
        'router_expert_b': nrm((DEPTH, N_EXPERTS), 0.01),
        'expert_w_gate': nrm((DEPTH, N_EXPERTS, D_MODEL, EXPERT_FF), D_MODEL ** -0.5),
        'expert_w_up': nrm((DEPTH, N_EXPERTS, D_MODEL, EXPERT_FF), D_MODEL ** -0.5),
        'expert_w_down': nrm((DEPTH, N_EXPERTS, EXPERT_FF, D_MODEL), EXPERT_FF ** -0.5),
    }


def reference(x, meta_tokens, norm1_w, w_in, rwkv_mu, rwkv_w0, rwkv_w2, rwkv_a0, rwkv_a2, rwkv_g2,
              rwkv_k_k, rwkv_k_a, rwkv_r_k, rwkv_ln_w, rwkv_ln_b, q_norm_w, k_norm_w,
              lambda_q1, lambda_k1, lambda_q2, lambda_k2, diff_subln_w, w_branch_rwkv, w_branch_diff,
              w_out, norm2_w, router_group_w, router_group_b, router_expert_w, router_expert_b,
              expert_w_gate, expert_w_up, expert_w_down):
    bsz = x.shape[0]
    meta = jnp.broadcast_to(meta_tokens[None].astype(x.dtype), (bsz, N_META, D_MODEL))
    h = jnp.concatenate([meta, x], axis=1)
    length = h.shape[1]
    pos = jnp.arange(length)
    for l in range(DEPTH):
        lambda_init = 0.8 - 0.6 * math.exp(-0.3 * l)
        u = rms_norm(h, norm1_w[l])
        proj = u @ w_in[l]
        p_rwkv = proj[..., :RWKV_COLS]
        p_diff = proj[..., RWKV_COLS:RWKV_COLS + DIFF_COLS]
        gates = jax.nn.sigmoid(proj[..., RWKV_COLS + DIFF_COLS:])
        y_rwkv = rwkv7_time_mix(p_rwkv, rwkv_mu[l], rwkv_w0[l], rwkv_w2[l], rwkv_a0[l], rwkv_a2[l],
                                rwkv_g2[l], rwkv_k_k[l], rwkv_k_a[l], rwkv_r_k[l],
                                rwkv_ln_w[l], rwkv_ln_b[l]) @ w_branch_rwkv[l]
        y_diff = diff_attention(p_diff, pos, q_norm_w[l], k_norm_w[l], lambda_q1[l], lambda_k1[l],
                                lambda_q2[l], lambda_k2[l], diff_subln_w[l], lambda_init) @ w_branch_diff[l]
        merged = gates[..., :D_MODEL] * y_rwkv + gates[..., D_MODEL:] * y_diff
        h = h + merged @ w_out[l]
        u2 = rms_norm(h, norm2_w[l]).reshape(-1, D_MODEL)
        h = h + hierarchical_moe(u2, router_group_w[l], router_group_b[l], router_expert_w[l],
                                 router_expert_b[l], expert_w_gate[l], expert_w_up[l],
                                 expert_w_down[l]).reshape(h.shape)
    return h[:, N_META:]
```

```cpp
#include <hip/hip_runtime.h>
#include <cstdio>
#include <cstdint>
#include <cmath>
constexpr int D = 1024, NB = 8, SEQ = 2048, NMETA = 16, MX = NB * SEQ  , MROWS = MX + NMETA  , MPAD = MX + 256;
constexpr int RW_COLS = 3328, DF_COLS = 3072, GT_COLS = 2048, IN_COLS = RW_COLS + DF_COLS + GT_COLS;
constexpr int NEXP = 32, EFF = 512;
constexpr float NORM_EPS = 1e-6f;
constexpr size_t MiB = 1u << 20;
constexpr size_t WS_CTL = 0, CTL_ZERO_BYTES = 1 * MiB;
constexpr size_t WS_SMALL = 1 * MiB;
constexpr size_t WS_WBR = 2 * MiB, WS_WBD = 4 * MiB, WS_WOUT = 6 * MiB;
constexpr size_t WS_WIN = 8 * MiB;
constexpr size_t WS_PG = 25 * MiB;
constexpr size_t WS_PR = 89 * MiB;
constexpr size_t WS_PD = 194 * MiB;
constexpr size_t WS_END = 291 * MiB;
static_assert(WS_WIN + (size_t)IN_COLS * D * 2 <= WS_PG && WS_PG + (size_t)MX * GT_COLS * 2 <= WS_PR && WS_PR + (size_t)MROWS * RW_COLS * 2 <= WS_PD && WS_PD + (size_t)MROWS * DF_COLS * 2 <= WS_END, "ws map");
constexpr size_t WS_MRG = 89 * MiB;
constexpr size_t WS_XN2 = 121 * MiB;
constexpr size_t WS_WGU = 154 * MiB;
constexpr size_t WS_WDN = 218 * MiB;
constexpr size_t WS_HID = 250 * MiB;
constexpr size_t WS_Y1 = 25 * MiB;
constexpr int CW_TMO = 0, CW_CODE = 1, CW_BAR = 4096, CW_QUEUE = 16384, CW_ROUTE = 32768;
namespace pg8 {
#define PG8_LAS __attribute__((address_space(3)))
typedef unsigned short bf16_t;
typedef short bf16x8 __attribute__((ext_vector_type(8)));
typedef float f32x4 __attribute__((ext_vector_type(4)));
typedef unsigned u32x4 __attribute__((ext_vector_type(4)));
constexpr int BM = 256, BK = 64, HALF = 128, HTB = HALF * BK * 2  , STAGE_BYTES = 8 * HTB, NXCD = 8, WGM = 8;

__host__ __device__ __forceinline__ int lds_byte(int r, int c) { const int st = (r >> 4) * 2 + (c >> 5), rr = r & 15, cc = c & 31, ob = rr * 64 + cc * 2; return st * 1024 + (ob ^ (((ob >> 9) & 1) << 5)); }
__host__ __device__ __forceinline__ void stage_rc(int b, int& R, int& C) { const int st = b / 1024, sb = b % 1024, swz = sb ^ (((sb >> 9) & 1) << 5); R = (st >> 1) * 16 + swz / 64; C = (st & 1) * 32 + (swz % 64) / 2; }
__host__ __device__ __forceinline__ int perm32(int rho) { const int n = rho >> 4, i = rho & 15; return 8 * (i >> 2) + 4 * n + (i & 3); }

struct Unit { int pm, pn; };
struct Gemm { const bf16_t* A; const bf16_t* Bt; int M, N, K; };

struct StaticOrder {
    int nM, nN, nwg, G, c;
    __host__ __device__ void init(int M, int N, int G_, int c_) { nM = M / BM; nN = N / BM; nwg = nM * nN; G = G_; c = c_; }
    __host__ __device__ bool next(int i, Unit& u) const {
        const long L = (long)i * G + c; if (L >= nwg) return false;
        int wgid = (int)L; { const int q = nwg / NXCD, r = nwg % NXCD, xcd = wgid % NXCD, off = wgid / NXCD; wgid = (xcd < r ? xcd * (q + 1) : r * (q + 1) + (xcd - r) * q) + off; }
        const int nig = WGM * nN, gid = wgid / nig, fm = gid * WGM, gsz = (nM - fm) < WGM ? (nM - fm) : WGM;
        u.pm = fm + ((wgid % nig) % gsz); u.pn = (wgid % nig) / gsz; return true;
    }
    __device__ __forceinline__ void a_ready(const Unit&) const {}
    __device__ __forceinline__ void done(const Unit&) const {}
};

__device__ __forceinline__ unsigned cvt_pk_bf16(float lo, float hi) { unsigned r; asm volatile("v_cvt_pk_bf16_f32 %0, %1, %2" : "=v"(r) : "v"(lo), "v"(hi)); return r; }
typedef float f32x2 __attribute__((ext_vector_type(2)));
template <class Epi, class Sched, bool ALIGN_EPI = false, bool SP2 = false>
__device__ __forceinline__ void gemm_phase(PG8_LAS unsigned char* lds, const Gemm g, const Sched& S, const Epi& E) {
    int tid_ = threadIdx.x; asm volatile("" : "+v"(tid_)); const int tid = tid_, wid = __builtin_amdgcn_readfirstlane(tid >> 6), lane = tid & 63, wr = wid >> 2, wc = wid & 3, fr = lane & 15, fq = lane >> 4;
    const int K = g.K, nt = K / BK;
    unsigned voffA[2], voffB[2];
#pragma unroll
    for (int i = 0; i < 2; ++i) { int R, C; stage_rc(tid * 16 + i * 8192, R, C); const int Rb = Epi::PERM ? ((R & ~31) + perm32(R & 31)) : R;
        voffA[i] = (unsigned)(R * K + C) * 2u; voffB[i] = (unsigned)(Rb * K + C) * 2u; }
    const size_t kstep = (size_t)(BK * 2);
    const size_t hstep = (size_t)HALF * K * 2;
    const size_t tstep = 2 * hstep;
    const unsigned ldsw = (unsigned)wid * 1024u;
    const int aoff = lds_byte(wr * 64 + fr, fq * 8), boff = lds_byte(wc * 32 + fr, fq * 8);
#define PG8_SA(b, h) (((b) * 2 + (h)) * HTB)
#define PG8_SB(b, h) ((4 + (b) * 2 + (h)) * HTB)
#define PG8_STAGE(bufoff, gbase, voff) do { _Pragma("unroll") for (int _i = 0; _i < 2; ++_i) \
        __builtin_amdgcn_global_load_lds((const unsigned*)((const char*)(gbase) + (voff)[_i]), (PG8_LAS unsigned*)(lds + (bufoff) + ldsw + _i * 8192), 16, 0, 0); } while (0)
#define PG8_LDA(dst, b, h) do { _Pragma("unroll") for (int m = 0; m < 4; ++m) _Pragma("unroll") for (int k = 0; k < 2; ++k) dst[m][k] = *(const PG8_LAS bf16x8*)(lds + PG8_SA(b, h) + aoff + m * 2048 + k * 1024); } while (0)
#define PG8_LDB(dst, b, h) do { _Pragma("unroll") for (int n = 0; n < 2; ++n) _Pragma("unroll") for (int k = 0; k < 2; ++k) dst[n][k] = *(const PG8_LAS bf16x8*)(lds + PG8_SB(b, h) + boff + n * 2048 + k * 1024); } while (0)
#define PG8_MMA(ai, bj, At, Bt) do { __builtin_amdgcn_s_setprio(1); _Pragma("unroll") for (int m = 0; m < 4; ++m) _Pragma("unroll") for (int n = 0; n < 2; ++n) _Pragma("unroll") for (int k = 0; k < 2; ++k) \
        acc[ai][bj][m][n] = __builtin_amdgcn_mfma_f32_16x16x32_bf16(Bt[n][k], At[m][k], acc[ai][bj][m][n], 0, 0, 0); __builtin_amdgcn_s_setprio(0); } while (0)
#define PG8_WAIT_V(n) asm volatile("s_waitcnt vmcnt(" #n ")" ::: "memory")
#define PG8_WAIT_L(n) asm volatile("s_waitcnt lgkmcnt(" #n ")" ::: "memory")
#define PG8_BAR __builtin_amdgcn_s_barrier()
#define PG8_SCHED __builtin_amdgcn_sched_barrier(0)
    Unit cur, nxt; int ui = 0;
    if (!S.next(0, cur)) return;
    f32x4 acc[2][2][4][2];
#pragma unroll
    for (int a = 0; a < 2; ++a)
#pragma unroll
        for (int b = 0; b < 2; ++b)
#pragma unroll
            for (int m = 0; m < 4; ++m)
#pragma unroll
                for (int n = 0; n < 2; ++n) acc[a][b][m][n] = (f32x4){0.f, 0.f, 0.f, 0.f};
    bf16x8 At[4][2], B0[2][2], B1[2][2];
    const char* cA = (const char*)g.A + (size_t)cur.pm * tstep; const char* cB = (const char*)g.Bt + (size_t)cur.pn * tstep;
    S.a_ready(cur);
    if constexpr (SP2) {
        PG8_STAGE(PG8_SB(0, 0), cB, voffB); PG8_STAGE(PG8_SB(0, 1), cB + hstep, voffB); PG8_STAGE(PG8_SA(0, 0), cA, voffA); PG8_STAGE(PG8_SA(0, 1), cA + hstep, voffA);
        if (wr == 1) PG8_BAR;
        PG8_WAIT_V(2); PG8_BAR;
        PG8_STAGE(PG8_SB(1, 0), cB + kstep, voffB); PG8_STAGE(PG8_SA(1, 0), cA + kstep, voffA); PG8_STAGE(PG8_SB(1, 1), cB + hstep + kstep, voffB);
        PG8_WAIT_V(6); PG8_BAR;
    } else {
        PG8_STAGE(PG8_SB(0, 0), cB, voffB); PG8_STAGE(PG8_SA(0, 0), cA, voffA); PG8_STAGE(PG8_SB(0, 1), cB + hstep, voffB); PG8_STAGE(PG8_SA(0, 1), cA + hstep, voffA);
        if (wr == 1) PG8_BAR;
        PG8_WAIT_V(4); PG8_BAR;
        PG8_STAGE(PG8_SB(1, 0), cB + kstep, voffB); PG8_STAGE(PG8_SA(1, 0), cA + kstep, voffA); PG8_STAGE(PG8_SB(1, 1), cB + hstep + kstep, voffB);
        PG8_WAIT_V(6); PG8_BAR;
    }
    for (;;) {
        const bool has_next = S.next(ui + 1, nxt);
        const char* nA = has_next ? (const char*)g.A + (size_t)nxt.pm * tstep : cA; const char* nB = has_next ? (const char*)g.Bt + (size_t)nxt.pn * tstep : cB;
        for (int t = 0; t < nt; t += 2) {
            const bool last = (t == nt - 2);
            const char* a1 = cA + (size_t)(t + 1) * kstep;
            const char* a2 = last ? nA : cA + (size_t)(t + 2) * kstep; const char* b2 = last ? nB : cB + (size_t)(t + 2) * kstep;
            const char* a3 = a2 + kstep; const char* b3 = b2 + kstep;
            if (last && has_next) S.a_ready(nxt);
            if constexpr (SP2) {
            PG8_LDB(B0, 0, 0); PG8_LDB(B1, 0, 1); PG8_SCHED; PG8_LDA(At, 0, 0); PG8_STAGE(PG8_SA(1, 1), a1 + hstep, voffA);
            PG8_WAIT_V(8); PG8_WAIT_L(0); PG8_BAR; PG8_MMA(0, 0, At, B0); PG8_MMA(0, 1, At, B1); PG8_BAR; PG8_SCHED;
            PG8_LDA(At, 0, 1); PG8_STAGE(PG8_SB(0, 0), b2, voffB); PG8_STAGE(PG8_SB(0, 1), b2 + hstep, voffB); PG8_STAGE(PG8_SA(0, 0), a2, voffA);
            PG8_WAIT_V(8); PG8_WAIT_L(0); PG8_BAR; PG8_MMA(1, 0, At, B0); PG8_MMA(1, 1, At, B1); PG8_BAR; PG8_SCHED;
            PG8_LDB(B0, 1, 0); PG8_LDB(B1, 1, 1); PG8_SCHED; PG8_LDA(At, 1, 0); PG8_STAGE(PG8_SA(0, 1), a2 + hstep, voffA);
            PG8_WAIT_V(8); PG8_WAIT_L(0); PG8_BAR; PG8_MMA(0, 0, At, B0); PG8_MMA(0, 1, At, B1); PG8_BAR; PG8_SCHED;
            PG8_LDA(At, 1, 1); PG8_STAGE(PG8_SB(1, 0), b3, voffB); PG8_STAGE(PG8_SB(1, 1), b3 + hstep, voffB); PG8_STAGE(PG8_SA(1, 0), a3, voffA);
            PG8_WAIT_V(8); PG8_WAIT_L(0); PG8_BAR; PG8_MMA(1, 0, At, B0); PG8_MMA(1, 1, At, B1); PG8_BAR; PG8_SCHED;
            } else {
            PG8_LDB(B0, 0, 0); PG8_SCHED; PG8_LDA(At, 0, 0); PG8_STAGE(PG8_SA(1, 1), a1 + hstep, voffA);
            PG8_WAIT_L(8); PG8_BAR; PG8_WAIT_L(0); PG8_MMA(0, 0, At, B0); PG8_BAR; PG8_SCHED;
            PG8_LDB(B1, 0, 1); PG8_STAGE(PG8_SB(0, 0), b2, voffB);
            PG8_BAR; PG8_WAIT_L(0); PG8_MMA(0, 1, At, B1); PG8_BAR;
            PG8_LDA(At, 0, 1); PG8_STAGE(PG8_SA(0, 0), a2, voffA);
            PG8_BAR; PG8_WAIT_L(0); PG8_MMA(1, 0, At, B0); PG8_BAR; PG8_SCHED;
            PG8_STAGE(PG8_SB(0, 1), b2 + hstep, voffB);
            PG8_WAIT_V(6); PG8_BAR; PG8_MMA(1, 1, At, B1); PG8_BAR;
            PG8_LDB(B0, 1, 0); PG8_SCHED; PG8_LDA(At, 1, 0); PG8_STAGE(PG8_SA(0, 1), a2 + hstep, voffA);
            PG8_WAIT_L(8); PG8_BAR; PG8_WAIT_L(0); PG8_MMA(0, 0, At, B0); PG8_BAR; PG8_SCHED;
            PG8_LDB(B1, 1, 1); PG8_STAGE(PG8_SB(1, 0), b3, voffB);
            PG8_BAR; PG8_WAIT_L(0); PG8_MMA(0, 1, At, B1); PG8_BAR;
            PG8_LDA(At, 1, 1); PG8_STAGE(PG8_SA(1, 0), a3, voffA);
            PG8_BAR; PG8_WAIT_L(0); PG8_MMA(1, 0, At, B0); PG8_BAR; PG8_SCHED;
            PG8_STAGE(PG8_SB(1, 1), b3 + hstep, voffB);
            PG8_WAIT_V(6); PG8_BAR; PG8_MMA(1, 1, At, B1); PG8_BAR;
            }
        }
        if constexpr (ALIGN_EPI) { if (wr == 0) PG8_BAR; }
        if constexpr (!Epi::AFTER_DRAIN) { E(acc, cur, wr, wc, fr, fq); S.done(cur); }
        if (!has_next) break;
#pragma unroll
        for (int a = 0; a < 2; ++a)
#pragma unroll
            for (int b = 0; b < 2; ++b)
#pragma unroll
                for (int m = 0; m < 4; ++m)
#pragma unroll
                    for (int n = 0; n < 2; ++n) acc[a][b][m][n] = (f32x4){0.f, 0.f, 0.f, 0.f};
        cur = nxt; cA = nA; cB = nB; ++ui;
        if constexpr (ALIGN_EPI) { if (wr == 1) PG8_BAR; }
    }
    PG8_WAIT_V(0);
    if constexpr (!ALIGN_EPI) { if (wr == 0) PG8_BAR; }
    PG8_BAR;
    if constexpr (Epi::AFTER_DRAIN) { E.fused(acc, cur, wr, wc, fr, fq, lds, wid, lane); S.done(cur); }
#undef PG8_SA
#undef PG8_SB
#undef PG8_STAGE
#undef PG8_LDA
#undef PG8_LDB
#undef PG8_MMA
#undef PG8_WAIT_V
#undef PG8_WAIT_L
#undef PG8_BAR
#undef PG8_SCHED
}
}
#define GAS __attribute__((address_space(1)))
#define LAS __attribute__((address_space(3)))
typedef unsigned short bf16;
typedef unsigned v4u __attribute__((ext_vector_type(4)));
typedef unsigned v2u __attribute__((ext_vector_type(2)));
typedef float f32x4 __attribute__((ext_vector_type(4)));
typedef float f32x2 __attribute__((ext_vector_type(2)));
typedef short bf16x8 __attribute__((ext_vector_type(8)));
typedef short s16x4 __attribute__((ext_vector_type(4)));
typedef float f32x16 __attribute__((ext_vector_type(16)));
typedef GAS unsigned gu32;
#define RLX_AGENT __ATOMIC_RELAXED, __HIP_MEMORY_SCOPE_AGENT
#define LDS_WAIT() asm volatile("s_waitcnt lgkmcnt(0)" ::: "memory")
#define VM_WAIT() asm volatile("s_waitcnt vmcnt(0)" ::: "memory")
constexpr int NWAVES = 8, NTHREADS = 512;
constexpr int LDS_BYTES = 160 * 1024;
constexpr int LDSCTL_OFF = LDS_BYTES - 512, MISC_OFF = LDSCTL_OFF + 256;
__device__ __forceinline__ unsigned f2bf(float f) { unsigned u = __builtin_bit_cast(unsigned, f); return (u + 0x7fffu + ((u >> 16) & 1u)) >> 16; }
__device__ __forceinline__ unsigned pk2(float lo, float hi) { return f2bf(lo) | (f2bf(hi) << 16); }
__device__ __forceinline__ float bf2f(unsigned short b) { return __builtin_bit_cast(float, (unsigned)b << 16); }
__device__ __forceinline__ float bflo(unsigned w) { return __builtin_bit_cast(float, w << 16); }
__device__ __forceinline__ float bfhi(unsigned w) { return __builtin_bit_cast(float, w & 0xffff0000u); }
__device__ __forceinline__ float sigmoidf_(float x) { return 1.0f / (1.0f + __expf(-x)); }
__device__ __forceinline__ float wave_sum(float v) {
#pragma unroll
    for (int o = 1; o < 64; o <<= 1) v += __shfl_xor(v, o);
    return v;
}
#define XB_TMO      128
#define XB_XCNT(j)  (256  + 64 * (j))
#define XB_XSUB(j)  (1280 + 64 * (j))
#define XB_XGEN(j)  (2304 + 64 * (j))
#define XB_TOP      3328
#define XB_TOPGEN   3392
#define XCD_BAR_WORDS 3456
#define XB_SPIN_CAP (1u << 18)

__device__ __forceinline__ unsigned xb_ld(unsigned* p)              { return __hip_atomic_load(p, __ATOMIC_RELAXED, __HIP_MEMORY_SCOPE_AGENT); }
__device__ __forceinline__ unsigned xb_add(unsigned* p, unsigned v) { return __hip_atomic_fetch_add(p, v, __ATOMIC_RELAXED, __HIP_MEMORY_SCOPE_AGENT); }
__device__ __forceinline__ unsigned xb_xcc_id() { return (unsigned)__builtin_amdgcn_s_getreg((3 << 11) | 20) & 0xFu; }
#define XB_SPIN(cond, bar) do { unsigned _sp = 0; while (cond) { __builtin_amdgcn_s_sleep(1); \
    if ((++_sp & 255u) == 0u) { if (xb_ld(&(bar)[XB_TMO])) break; if (_sp > XB_SPIN_CAP) { atomicAdd(&(bar)[XB_TMO], 1u); break; } } } } while (0)

struct XcdBarrier {
    unsigned* bar; unsigned x;
    volatile LAS unsigned* st;
};

__device__ __forceinline__ XcdBarrier xcd_barrier_post(unsigned* bar, volatile LAS unsigned* st) {
    XcdBarrier b; b.bar = bar; b.x = xb_xcc_id(); b.st = st;
    if (threadIdx.x == 0) (void)xb_add(&bar[XB_XCNT(b.x)], 1u);
    return b;
}
__device__ __forceinline__ void xcd_barrier_complete(unsigned* bar, unsigned x, unsigned& nloc, unsigned& nx) {
    const unsigned G = gridDim.x * gridDim.y * gridDim.z;
    unsigned sum, cnt, mine, sp = 0u;
    for (;;) {
        sum = 0u; cnt = 0u; mine = 0u;
#pragma unroll
        for (unsigned j = 0; j < 16; ++j) { const unsigned c = xb_ld(&bar[XB_XCNT(j)]); sum += c; cnt += (c > 0u) ? 1u : 0u; mine = (j == x) ? c : mine; }
        if (sum == G) break;
        __builtin_amdgcn_s_sleep(1);
        if ((++sp & 255u) == 0u) { if (xb_ld(&bar[XB_TMO])) break; if (sp > XB_SPIN_CAP) { atomicAdd(&bar[XB_TMO], 1u); break; } }
    }
    nloc = mine > 0u ? mine : 1u; nx = cnt > 0u ? cnt : 1u;
}

__device__ __forceinline__ void xcd_barrier(const XcdBarrier& b) {
    asm volatile("s_waitcnt vmcnt(0)" ::: "memory");
    __syncthreads();
    if (threadIdx.x == 0) {
        unsigned* bar = b.bar;
        __builtin_amdgcn_s_waitcnt(0);
        unsigned nloc = b.st[0], nx = b.st[1];
        if (nloc == 0u) { xcd_barrier_complete(bar, b.x, nloc, nx); b.st[0] = nloc; b.st[1] = nx; }
        const unsigned old = xb_add(&bar[XB_XSUB(b.x)], 1u);
        const unsigned gen = old / nloc;
        if (old + 1u == (gen + 1u) * nloc) {
            __builtin_amdgcn_fence(__ATOMIC_RELEASE, "agent");
            asm volatile("s_waitcnt vmcnt(0)" ::: "memory");
            const unsigned og = xb_add(&bar[XB_TOP], 1u);
            const unsigned tg = og / nx;
            if (og + 1u == (tg + 1u) * nx) xb_add(&bar[XB_TOPGEN], 1u);
            else XB_SPIN(xb_ld(&bar[XB_TOPGEN]) == tg, bar);
            __builtin_amdgcn_fence(__ATOMIC_ACQUIRE, "agent");
            xb_add(&bar[XB_XGEN(b.x)], 1u);
            asm volatile("s_waitcnt vmcnt(0)" ::: "memory");
        } else {
            XB_SPIN(xb_ld(&bar[XB_XGEN(b.x)]) == gen, bar);
            __builtin_amdgcn_fence(__ATOMIC_ACQUIRE, "agent");
            asm volatile("s_waitcnt vmcnt(0)" ::: "memory");
        }
    }
    __syncthreads();
}
namespace pg8 {
struct EpiInProj {
    static constexpr bool PERM = true, AFTER_DRAIN = false;
    bf16_t* PR; bf16_t* PD; bf16_t* PG;
    __device__ __forceinline__ void operator()(const f32x4 (&acc)[2][2][4][2], const Unit& u, int wr, int wc, int fr, int fq) const {
        bf16_t* base; int ldc, colt, rowlim; bool sg = false;
        if (u.pn < 13) { base = PR; ldc = 3328; colt = u.pn * 256; rowlim = 16400; }
        else if (u.pn < 25) { base = PD; ldc = 3072; colt = (u.pn - 13) * 256; rowlim = 16400; }
        else { base = PG; ldc = 2048; colt = (u.pn - 25) * 256; rowlim = 16384; sg = true; }
        const int row0 = u.pm * BM + wr * 64 + fr, col0 = colt + wc * 32 + 8 * fq;
#pragma unroll
        for (int ai = 0; ai < 2; ++ai)
#pragma unroll
            for (int m = 0; m < 4; ++m) { const int row = row0 + ai * HALF + m * 16; bf16_t* rowp = base + (size_t)row * ldc + col0;
                if (row < rowlim) {
#pragma unroll
                for (int bj = 0; bj < 2; ++bj) { f32x4 v0 = acc[ai][bj][m][0], v1 = acc[ai][bj][m][1];
                    if (sg) {
#pragma unroll
                        for (int e = 0; e < 4; ++e) { v0[e] = 1.0f / (1.0f + __expf(-v0[e])); v1[e] = 1.0f / (1.0f + __expf(-v1[e])); } }
                    u32x4 w; w.x = cvt_pk_bf16(v0[0], v0[1]); w.y = cvt_pk_bf16(v0[2], v0[3]); w.z = cvt_pk_bf16(v1[0], v1[1]); w.w = cvt_pk_bf16(v1[2], v1[3]);
                    *(u32x4*)(rowp + bj * HALF) = w; } } }
    }
};
struct InProjOrder {
    StaticOrder so; int G, c;
    __device__ void init(int G_, int c_) { so.init(16384, 8448, G_, c_); G = G_; c = c_; }
    __device__ bool next(int i, Unit& u) const {
        if (so.next(i, u)) return true;
        const long L = (long)i * G + c - so.nwg; if (L < 0 || L >= 21) return false;
        u.pm = 64; u.pn = (L < 13) ? (int)L : (int)L + 4; return true;
    }
    __device__ __forceinline__ void a_ready(const Unit&) const {}
    __device__ __forceinline__ void done(const Unit&) const {}
};
}
namespace pg8 {
struct EpiGate {
    static constexpr bool PERM = true, AFTER_DRAIN = false;
    const bf16_t* PG; int goff; const bf16_t* T1; bf16_t* O;
    __device__ __forceinline__ void operator()(const f32x4 (&acc)[2][2][4][2], const Unit& u, int wr, int wc, int fr, int fq) const {
        const int row0 = u.pm * BM + wr * 64 + fr, col0 = u.pn * BM + wc * 32 + 8 * fq;
#pragma unroll
        for (int ai = 0; ai < 2; ++ai)
#pragma unroll
            for (int m = 0; m < 4; ++m) { const size_t row = row0 + ai * HALF + m * 16;
#pragma unroll
                for (int bj = 0; bj < 2; ++bj) { const int col = col0 + bj * HALF;
                    const u32x4 gw = *(const u32x4*)(PG + row * 2048 + goff + col);
                    f32x4 v0 = acc[ai][bj][m][0], v1 = acc[ai][bj][m][1];
                    v0[0] *= __builtin_bit_cast(float, gw.x << 16); v0[1] *= __builtin_bit_cast(float, gw.x & 0xffff0000u); v0[2] *= __builtin_bit_cast(float, gw.y << 16); v0[3] *= __builtin_bit_cast(float, gw.y & 0xffff0000u);
                    v1[0] *= __builtin_bit_cast(float, gw.z << 16); v1[1] *= __builtin_bit_cast(float, gw.z & 0xffff0000u); v1[2] *= __builtin_bit_cast(float, gw.w << 16); v1[3] *= __builtin_bit_cast(float, gw.w & 0xffff0000u);
                    if (T1) { const u32x4 tw = *(const u32x4*)(T1 + row * 1024 + col);
                        v0[0] += __builtin_bit_cast(float, tw.x << 16); v0[1] += __builtin_bit_cast(float, tw.x & 0xffff0000u); v0[2] += __builtin_bit_cast(float, tw.y << 16); v0[3] += __builtin_bit_cast(float, tw.y & 0xffff0000u);
                        v1[0] += __builtin_bit_cast(float, tw.z << 16); v1[1] += __builtin_bit_cast(float, tw.z & 0xffff0000u); v1[2] += __builtin_bit_cast(float, tw.w << 16); v1[3] += __builtin_bit_cast(float, tw.w & 0xffff0000u); }
                    u32x4 w; w.x = cvt_pk_bf16(v0[0], v0[1]); w.y = cvt_pk_bf16(v0[2], v0[3]); w.z = cvt_pk_bf16(v1[0], v1[1]); w.w = cvt_pk_bf16(v1[2], v1[3]);
                    *(u32x4*)(O + row * 1024 + col) = w; } }
    }
};
struct EpiResF32 {
    static constexpr bool PERM = false, AFTER_DRAIN = false;
    const float* res; float* O;
    __device__ __forceinline__ void operator()(const f32x4 (&acc)[2][2][4][2], const Unit& u, int wr, int wc, int fr, int fq) const {
        const int row0 = u.pm * BM + wr * 64 + fr, col0 = u.pn * BM + wc * 32 + 4 * fq;
#pragma unroll
        for (int ai = 0; ai < 2; ++ai)
#pragma unroll
            for (int m = 0; m < 4; ++m) { const size_t off = (size_t)(row0 + ai * HALF + m * 16) * 1024 + col0;
#pragma unroll
                for (int bj = 0; bj < 2; ++bj)
#pragma unroll
                    for (int n = 0; n < 2; ++n) { const f32x4 r = *(const f32x4*)(res + off + bj * HALF + n * 16); *(f32x4*)(O + off + bj * HALF + n * 16) = r + acc[ai][bj][m][n]; } }
    }
};
}
namespace pg8 {
template <class Epi, class Sched>
__device__ __forceinline__ void gemm_phase_g(PG8_LAS unsigned char* lds, const Gemm g, const Sched& S, const Epi& E) {
    int tid_ = threadIdx.x; asm volatile("" : "+v"(tid_)); const int tid = tid_, wid = __builtin_amdgcn_readfirstlane(tid >> 6), lane = tid & 63, wr = wid >> 2, wc = wid & 3, fr = lane & 15, fq = lane >> 4;
    const int K = g.K, nt = K / BK;
    int RA[2], CA2[2]; unsigned voffB[2];
#pragma unroll
    for (int i = 0; i < 2; ++i) { int R, C; stage_rc(tid * 16 + i * 8192, R, C); const int Rb = Epi::PERM ? ((R & ~31) + perm32(R & 31)) : R; RA[i] = R; CA2[i] = C * 2; voffB[i] = (unsigned)(Rb * K + C) * 2u; }
    const size_t kstep = (size_t)(BK * 2);
    const size_t hstep = (size_t)HALF * K * 2;
    const size_t tstep = 2 * hstep;
    const unsigned ldsw = (unsigned)wid * 1024u;
    const int aoff = lds_byte(wr * 64 + fr, fq * 8), boff = lds_byte(wc * 32 + fr, fq * 8);
#define PG8_SA(b, h) (((b) * 2 + (h)) * HTB)
#define PG8_SB(b, h) ((4 + (b) * 2 + (h)) * HTB)
#define PG8_STAGE(bufoff, gbase, voff) do { _Pragma("unroll") for (int _i = 0; _i < 2; ++_i) \
        __builtin_amdgcn_global_load_lds((const unsigned*)((const char*)(gbase) + (voff)[_i]), (PG8_LAS unsigned*)(lds + (bufoff) + ldsw + _i * 8192), 16, 0, 0); } while (0)
#define PG8_STAGEA(bufoff, O, h, kb) do { _Pragma("unroll") for (int _i = 0; _i < 2; ++_i) \
        __builtin_amdgcn_global_load_lds((const unsigned*)((const char*)g.A + (size_t)(O)[h][_i] + (kb)), (PG8_LAS unsigned*)(lds + (bufoff) + ldsw + _i * 8192), 16, 0, 0); } while (0)
#define PG8_LDA(dst, b, h) do { _Pragma("unroll") for (int m = 0; m < 4; ++m) _Pragma("unroll") for (int k = 0; k < 2; ++k) dst[m][k] = *(const PG8_LAS bf16x8*)(lds + PG8_SA(b, h) + aoff + m * 2048 + k * 1024); } while (0)
#define PG8_LDB(dst, b, h) do { _Pragma("unroll") for (int n = 0; n < 2; ++n) _Pragma("unroll") for (int k = 0; k < 2; ++k) dst[n][k] = *(const PG8_LAS bf16x8*)(lds + PG8_SB(b, h) + boff + n * 2048 + k * 1024); } while (0)
#define PG8_MMA(ai, bj, At, Bt) do { __builtin_amdgcn_s_setprio(1); _Pragma("unroll") for (int m = 0; m < 4; ++m) _Pragma("unroll") for (int n = 0; n < 2; ++n) _Pragma("unroll") for (int k = 0; k < 2; ++k) \
        acc[ai][bj][m][n] = __builtin_amdgcn_mfma_f32_16x16x32_bf16(Bt[n][k], At[m][k], acc[ai][bj][m][n], 0, 0, 0); __builtin_amdgcn_s_setprio(0); } while (0)
#define PG8_WAIT_V(n) asm volatile("s_waitcnt vmcnt(" #n ")" ::: "memory")
#define PG8_WAIT_L(n) asm volatile("s_waitcnt lgkmcnt(" #n ")" ::: "memory")
#define PG8_BAR __builtin_amdgcn_s_barrier()
#define PG8_SCHED __builtin_amdgcn_sched_barrier(0)
#define PG8_AOFF(O, u) do { _Pragma("unroll") for (int _h = 0; _h < 2; ++_h) _Pragma("unroll") for (int _i = 0; _i < 2; ++_i) (O)[_h][_i] = S.a_row_off((u), _h * HALF + RA[_i]) + (unsigned)CA2[_i]; } while (0)
    Unit cur, nxt; int ui = 0;
    if (!S.next(0, cur)) return;
    f32x4 acc[2][2][4][2];
#pragma unroll
    for (int a = 0; a < 2; ++a)
#pragma unroll
        for (int b = 0; b < 2; ++b)
#pragma unroll
            for (int m = 0; m < 4; ++m)
#pragma unroll
                for (int n = 0; n < 2; ++n) acc[a][b][m][n] = (f32x4){0.f, 0.f, 0.f, 0.f};
    bf16x8 At[4][2], B0[2][2], B1[2][2];
    unsigned cO[2][2], nO[2][2];
    PG8_AOFF(cO, cur);
    const char* cB = (const char*)g.Bt + (size_t)cur.pn * tstep;
    PG8_STAGE(PG8_SB(0, 0), cB, voffB); PG8_STAGE(PG8_SB(0, 1), cB + hstep, voffB); PG8_STAGEA(PG8_SA(0, 0), cO, 0, 0); PG8_STAGEA(PG8_SA(0, 1), cO, 1, 0);
    if (wr == 1) PG8_BAR;
    PG8_WAIT_V(2); PG8_BAR;
    PG8_STAGE(PG8_SB(1, 0), cB + kstep, voffB); PG8_STAGEA(PG8_SA(1, 0), cO, 0, kstep); PG8_STAGE(PG8_SB(1, 1), cB + hstep + kstep, voffB);
    PG8_WAIT_V(6); PG8_BAR;
    for (;;) {
        const bool has_next = S.next(ui + 1, nxt);
        if (has_next) { PG8_AOFF(nO, nxt); } else {
#pragma unroll
            for (int _h = 0; _h < 2; ++_h)
#pragma unroll
                for (int _i = 0; _i < 2; ++_i) nO[_h][_i] = cO[_h][_i]; }
        const char* nB = has_next ? (const char*)g.Bt + (size_t)nxt.pn * tstep : cB;
        for (int t = 0; t < nt; t += 2) {
            const bool last = (t == nt - 2);
            const size_t k1 = (size_t)(t + 1) * kstep, k2 = last ? 0 : (size_t)(t + 2) * kstep, k3 = k2 + kstep;
            unsigned o2[2][2];
#pragma unroll
            for (int _h = 0; _h < 2; ++_h)
#pragma unroll
                for (int _i = 0; _i < 2; ++_i) o2[_h][_i] = last ? nO[_h][_i] : cO[_h][_i];
            const char* b2 = last ? nB : cB + (size_t)(t + 2) * kstep; const char* b3 = b2 + kstep;
            PG8_LDB(B0, 0, 0); PG8_LDB(B1, 0, 1); PG8_SCHED; PG8_LDA(At, 0, 0); PG8_STAGEA(PG8_SA(1, 1), cO, 1, k1);
            PG8_WAIT_V(8); PG8_WAIT_L(0); PG8_BAR; PG8_MMA(0, 0, At, B0); PG8_MMA(0, 1, At, B1); PG8_BAR; PG8_SCHED;
            PG8_LDA(At, 0, 1); PG8_STAGE(PG8_SB(0, 0), b2, voffB); PG8_STAGE(PG8_SB(0, 1), b2 + hstep, voffB); PG8_STAGEA(PG8_SA(0, 0), o2, 0, k2);
            PG8_WAIT_V(8); PG8_WAIT_L(0); PG8_BAR; PG8_MMA(1, 0, At, B0); PG8_MMA(1, 1, At, B1); PG8_BAR; PG8_SCHED;
            PG8_LDB(B0, 1, 0); PG8_LDB(B1, 1, 1); PG8_SCHED; PG8_LDA(At, 1, 0); PG8_STAGEA(PG8_SA(0, 1), o2, 1, k2);
            PG8_WAIT_V(8); PG8_WAIT_L(0); PG8_BAR; PG8_MMA(0, 0, At, B0); PG8_MMA(0, 1, At, B1); PG8_BAR; PG8_SCHED;
            PG8_LDA(At, 1, 1); PG8_STAGE(PG8_SB(1, 0), b3, voffB); PG8_STAGE(PG8_SB(1, 1), b3 + hstep, voffB); PG8_STAGEA(PG8_SA(1, 0), o2, 0, k3);
            PG8_WAIT_V(8); PG8_WAIT_L(0); PG8_BAR; PG8_MMA(1, 0, At, B0); PG8_MMA(1, 1, At, B1); PG8_BAR; PG8_SCHED;
        }
        if (wr == 0) PG8_BAR;
        E(acc, cur, wr, wc, fr, fq);
        if (!has_next) break;
#pragma unroll
        for (int a = 0; a < 2; ++a)
#pragma unroll
            for (int b = 0; b < 2; ++b)
#pragma unroll
                for (int m = 0; m < 4; ++m)
#pragma unroll
                    for (int n = 0; n < 2; ++n) acc[a][b][m][n] = (f32x4){0.f, 0.f, 0.f, 0.f};
        cur = nxt; cB = nB; ++ui;
#pragma unroll
        for (int _h = 0; _h < 2; ++_h)
#pragma unroll
            for (int _i = 0; _i < 2; ++_i) cO[_h][_i] = nO[_h][_i];
        if (wr == 1) PG8_BAR;
    }
    PG8_WAIT_V(0);
    PG8_BAR;
#undef PG8_SA
#undef PG8_SB
#undef PG8_STAGE
#undef PG8_STAGEA
#undef PG8_LDA
#undef PG8_LDB
#undef PG8_MMA
#undef PG8_WAIT_V
#undef PG8_WAIT_L
#undef PG8_BAR
#undef PG8_SCHED
#undef PG8_AOFF
}
}
__device__ __forceinline__ void transpose_item(const float* W, int N, bf16* WT, int ldt, int drow, int k0, int n0, LAS float* scr, int lane) {
#pragma unroll 8
    for (int i = 0; i < 32; ++i) { const int kk = 2 * i + (lane >> 5); scr[kk * 33 + (lane & 31)] = W[(size_t)(k0 + kk) * N + n0 + (lane & 31)]; }
    LDS_WAIT(); asm volatile("" ::: "memory");
    const int c = lane & 7;
#pragma unroll
    for (int j = 0; j < 4; ++j) { const int n = (lane >> 3) + 8 * j; const LAS float* s = scr + (8 * c) * 33 + n;
        v4u o; o.x = pk2(s[0 * 33], s[1 * 33]); o.y = pk2(s[2 * 33], s[3 * 33]); o.z = pk2(s[4 * 33], s[5 * 33]); o.w = pk2(s[6 * 33], s[7 * 33]);
        *(GAS v4u*)(WT + (size_t)(drow + n) * ldt + k0 + 8 * c) = o; }
    LDS_WAIT(); asm volatile("" ::: "memory");
}
__device__ __forceinline__ void rms_row_to_bf16(const float* xrow, const float* w, bf16* orow, int lane) {
    const GAS f32x4* xr = (const GAS f32x4*)xrow + lane; const GAS f32x4* wr = (const GAS f32x4*)w + lane;
    f32x4 v[4]; float s2 = 0.f;
#pragma unroll
    for (int j = 0; j < 4; ++j) { v[j] = xr[64 * j]; s2 += (v[j].x * v[j].x + v[j].y * v[j].y) + (v[j].z * v[j].z + v[j].w * v[j].w); }
    const float rstd = 1.f / sqrtf(wave_sum(s2) * (1.f / D) + NORM_EPS);
    GAS unsigned long long* o8 = (GAS unsigned long long*)orow + lane;
#pragma unroll
    for (int j = 0; j < 4; ++j) { const f32x4 g = wr[64 * j];
        o8[64 * j] = (unsigned long long)pk2(v[j].x * rstd * g.x, v[j].y * rstd * g.y) | ((unsigned long long)pk2(v[j].z * rstd * g.z, v[j].w * rstd * g.w) << 32); }
}
constexpr float ATT_C2 = 0.125f * 1.4426950408889634f;
__device__ __forceinline__ void qk_prepass_row(bf16* prow, int pos, bool do_q, const float* qnw, const float* knw, int lane) {
#pragma unroll
    for (int ps = 0; ps < 4; ++ps) {
        const bool isq = ps < 2;
        if (isq && !do_q) continue;
        const int col = ps * 512 + lane * 8, dl = (lane & 7) * 8;
        v4u raw = *(const GAS v4u*)(prow + col);
        float v[8]; v[0] = bflo(raw.x); v[1] = bfhi(raw.x); v[2] = bflo(raw.y); v[3] = bfhi(raw.y); v[4] = bflo(raw.z); v[5] = bfhi(raw.z); v[6] = bflo(raw.w); v[7] = bfhi(raw.w);
        float ss = 0.f;
#pragma unroll
        for (int j = 0; j < 8; ++j) ss += v[j] * v[j];
        ss += __shfl_xor(ss, 1); ss += __shfl_xor(ss, 2); ss += __shfl_xor(ss, 4);
        const float rstd = 1.f / sqrtf(ss * (1.f / 64.f) + NORM_EPS);
        const float* nw = isq ? qnw : knw;
#pragma unroll
        for (int j = 0; j < 8; ++j) v[j] = v[j] * rstd * nw[dl + j];
        float oth[8];
#pragma unroll
        for (int j = 0; j < 8; ++j) oth[j] = __shfl_xor(v[j], 1);
        if (dl < 16) {
#pragma unroll
            for (int j = 0; j < 8; ++j) {
                const float invf = expf(-13.122363377404328f * (float)j * 2.0f / 16.0f);
                float sn, cs; sincosf((float)pos * invf, &sn, &cs);
                v[j] = (dl == 0) ? (v[j] * cs - oth[j] * sn) : (v[j] * cs + oth[j] * sn);
            }
        }
        if (isq) {
#pragma unroll
            for (int j = 0; j < 8; ++j) v[j] *= ATT_C2;
        }
        v4u o; o.x = pk2(v[0], v[1]); o.y = pk2(v[2], v[3]); o.z = pk2(v[4], v[5]); o.w = pk2(v[6], v[7]);
        *(GAS v4u*)(prow + col) = o;
    }
}

namespace att {
constexpr int SLOTB = 32768, L_K0 = 0, L_K1 = 8192, L_V = 16384, L_WS = 65536, L_X = 67584, L_END = L_X + 65536;
static_assert(L_END <= LDSCTL_OFF, "attention LDS");
__device__ __forceinline__ int crow(int r, int hi) { return (r & 3) + 8 * (r >> 2) + 4 * hi; }
__device__ __forceinline__ int key_row(int b, int pos) { int s = pos - NMETA; s = s > SEQ - 1 ? SEQ - 1 : s; return pos < NMETA ? MX + pos : b * SEQ + s; }
__device__ __forceinline__ s16x4 vtr(LAS const unsigned char* p) { typedef short v4i16_t __attribute__((ext_vector_type(4)));
    return __builtin_bit_cast(s16x4, __builtin_amdgcn_ds_read_tr16_b64_v4i16((LAS v4i16_t*)p)); }
__device__ __forceinline__ unsigned cvtpk(float lo, float hi) { typedef __bf16 bf16x2_t __attribute__((ext_vector_type(2))); f32x2 v = {lo, hi}; bf16x2_t b = __builtin_convertvector(v, bf16x2_t); return __builtin_bit_cast(unsigned, b); }

__device__ __forceinline__ void unit(LAS unsigned char* lds, const bf16* PD, bf16* DO, int b, int h, int qb, float lam, const float* subw) {
    int tid_ = threadIdx.x; asm volatile("" : "+v"(tid_)); const int tid = tid_, lane = tid & 63, r32 = lane & 31, hi = lane >> 5; const int wid = __builtin_amdgcn_readfirstlane(tid >> 6);
    const int c = wid >> 2, wq = wid & 3;
    const int NT = 2 * qb + 3;
    const int qpos = NMETA + 128 * qb + 32 * wq + r32;
    bf16x8 qr[4];
    { const bf16* qp = PD + (size_t)(b * SEQ + 128 * qb + 32 * wq + r32) * DF_COLS + h * 128 + c * 64 + hi * 8;
#pragma unroll
      for (int d0 = 0; d0 < 4; ++d0) qr[d0] = *(const GAS bf16x8*)(qp + d0 * 16); }
    const int kp = wid, vp0i = wid, vp1i = wid + 8;
    v4u sk0, sk1, sv0, sv1;
#define ATT_LOAD(t) do { const int pk = 64 * (t) + lane; const bf16* kr = PD + (size_t)key_row(b, pk) * DF_COLS + 1024 + h * 128 + kp * 8; \
        sk0 = *(const GAS v4u*)(kr); sk1 = *(const GAS v4u*)(kr + 64); \
        const int pv0 = 64 * (t) + 16 * (vp0i & 3) + (lane >> 2), pv1 = 64 * (t) + 16 * (vp1i & 3) + (lane >> 2); \
        sv0 = *(const GAS v4u*)(PD + (size_t)key_row(b, pv0) * DF_COLS + 2048 + h * 128 + 32 * (vp0i >> 2) + (lane & 3) * 8); \
        sv1 = *(const GAS v4u*)(PD + (size_t)key_row(b, pv1) * DF_COLS + 2048 + h * 128 + 32 * (vp1i >> 2) + (lane & 3) * 8); } while (0)
#define ATT_WRITE(slot) do { LAS unsigned char* sb = lds + (slot) * SLOTB; \
        *(LAS v4u*)(sb + L_K0 + kp * 1024 + lane * 16) = sk0; *(LAS v4u*)(sb + L_K1 + kp * 1024 + lane * 16) = sk1; \
        *(LAS v4u*)(sb + L_V + vp0i * 1024 + lane * 16) = sv0; *(LAS v4u*)(sb + L_V + vp1i * 1024 + lane * 16) = sv1; } while (0)
    LAS float* wsf = (LAS float*)(lds + L_WS) + wid * 64;
    f32x16 o[4];
#pragma unroll
    for (int i = 0; i < 4; ++i) o[i] = f32x16{};
    float mrun = -INFINITY, lrun = 0.f;
    ATT_LOAD(0); ATT_WRITE(0);
    __syncthreads();
    for (int t = 0; t < NT; ++t) {
        if (t + 1 < NT) ATT_LOAD(t + 1);
        LAS const unsigned char* sb = lds + (t & 1) * SLOTB;
        f32x16 p0 = f32x16{}, p1 = f32x16{};
        { LAS const unsigned char* kb = sb + (c ? L_K1 : L_K0) + hi * 1024 + r32 * 16;
#pragma unroll
          for (int d0 = 0; d0 < 4; ++d0) {
              const bf16x8 b0 = *(LAS const bf16x8*)(kb + d0 * 2048); const bf16x8 b1 = *(LAS const bf16x8*)(kb + d0 * 2048 + 512);
              p0 = __builtin_amdgcn_mfma_f32_32x32x16_bf16(b0, qr[d0], p0, 0, 0, 0); p1 = __builtin_amdgcn_mfma_f32_32x32x16_bf16(b1, qr[d0], p1, 0, 0, 0); } }
        if (64 * t + 63 > NMETA + 128 * qb + 32 * wq) {
#pragma unroll
            for (int r = 0; r < 16; ++r) { const int kv = 64 * t + crow(r, hi); if (kv > qpos) p0[r] = -INFINITY; if (kv + 32 > qpos) p1[r] = -INFINITY; }
        }
        float rm = fmaxf(p0[0], p1[0]);
#pragma unroll
        for (int r = 1; r < 16; ++r) rm = fmaxf(rm, fmaxf(p0[r], p1[r]));
        rm = fmaxf(rm, __shfl_xor(rm, 32));
        const float mn = fmaxf(mrun, rm); const float alpha = __builtin_amdgcn_exp2f(mrun - mn); mrun = mn;
        float sacc = 0.f;
#pragma unroll
        for (int r = 0; r < 16; ++r) { p0[r] = __builtin_amdgcn_exp2f(p0[r] - mn); p1[r] = __builtin_amdgcn_exp2f(p1[r] - mn); sacc += p0[r] + p1[r]; }
        lrun = lrun * alpha + sacc;
        if (hi == 0) wsf[r32] = alpha;
        asm volatile("s_waitcnt lgkmcnt(0)" ::: "memory");
#pragma unroll
        for (int r = 0; r < 16; ++r) { const float f = wsf[crow(r, hi)];
#pragma unroll
            for (int d0 = 0; d0 < 4; ++d0) o[d0][r] *= f; }
        v4u pw[4];
        pw[0] = (v4u){cvtpk(p0[0], p0[1]), cvtpk(p0[2], p0[3]), cvtpk(p0[4], p0[5]), cvtpk(p0[6], p0[7])};
        pw[1] = (v4u){cvtpk(p0[8], p0[9]), cvtpk(p0[10], p0[11]), cvtpk(p0[12], p0[13]), cvtpk(p0[14], p0[15])};
        pw[2] = (v4u){cvtpk(p1[0], p1[1]), cvtpk(p1[2], p1[3]), cvtpk(p1[4], p1[5]), cvtpk(p1[6], p1[7])};
        pw[3] = (v4u){cvtpk(p1[8], p1[9]), cvtpk(p1[10], p1[11]), cvtpk(p1[12], p1[13]), cvtpk(p1[14], p1[15])};
        { LAS const unsigned char* vb = sb + L_V + ((lane >> 4) & 1) * 32 + (lane & 3) * 8 + (4 * hi + ((lane & 15) >> 2)) * 64;
#pragma unroll
          for (int d0 = 0; d0 < 4; ++d0)
#pragma unroll
              for (int ks = 0; ks < 4; ++ks) {
                  const s16x4 lo = vtr(vb + d0 * 4096 + ks * 1024), hh = vtr(vb + d0 * 4096 + ks * 1024 + 512);
                  const bf16x8 vf = (bf16x8){lo[0], lo[1], lo[2], lo[3], hh[0], hh[1], hh[2], hh[3]};
                  o[d0] = __builtin_amdgcn_mfma_f32_32x32x16_bf16(__builtin_bit_cast(bf16x8, pw[ks]), vf, o[d0], 0, 0, 0); } }
        if (t + 1 < NT) ATT_WRITE((t + 1) & 1);
        __syncthreads();
    }
#undef ATT_LOAD
#undef ATT_WRITE
    lrun += __shfl_xor(lrun, 32);
    if (hi == 0) wsf[32 + r32] = 1.0f / lrun;
    asm volatile("s_waitcnt lgkmcnt(0)" ::: "memory");
    float rli[16];
#pragma unroll
    for (int r = 0; r < 16; ++r) rli[r] = wsf[32 + crow(r, hi)];
    LAS float* X = (LAS float*)(lds + L_X) + wq * 4096;
    if (c == 1) {
#pragma unroll
        for (int d0 = 0; d0 < 4; ++d0)
#pragma unroll
            for (int r = 0; r < 16; ++r) X[(d0 * 16 + r) * 64 + lane] = o[d0][r] * rli[r];
    }
    __syncthreads();
    if (c == 0) {
        float ss[16];
#pragma unroll
        for (int r = 0; r < 16; ++r) { float s = 0.f;
#pragma unroll
            for (int d0 = 0; d0 < 4; ++d0) { const float v = o[d0][r] * rli[r] - lam * X[(d0 * 16 + r) * 64 + lane]; o[d0][r] = v; s += v * v; }
            ss[r] = s; }
#pragma unroll
        for (int r = 0; r < 16; ++r) {
#pragma unroll
            for (int off = 1; off < 32; off <<= 1) ss[r] += __shfl_xor(ss[r], off);
            ss[r] = 1.f / sqrtf(ss[r] * (1.f / 128.f) + NORM_EPS); }
        asm volatile("s_waitcnt lgkmcnt(0)" ::: "memory");
        LAS bf16* stg = (LAS bf16*)(lds + L_X + wq * 16384);
        float sw[4];
#pragma unroll
        for (int d0 = 0; d0 < 4; ++d0) sw[d0] = subw[32 * d0 + r32] * 0.8f;
#pragma unroll
        for (int r = 0; r < 16; ++r)
#pragma unroll
            for (int d0 = 0; d0 < 4; ++d0) stg[crow(r, hi) * 128 + 32 * d0 + r32] = (bf16)f2bf(o[d0][r] * ss[r] * sw[d0]);
    }
    __syncthreads();
    {
#pragma unroll
        for (int i = 0; i < 4; ++i) { const int id = tid + 512 * i, row = id >> 4, ch = id & 15;
            const v4u v = *(LAS const v4u*)(lds + L_X + (row >> 5) * 16384 + (row & 31) * 256 + ch * 16);
            *(GAS v4u*)(DO + (size_t)(b * SEQ + 128 * qb + row) * D + h * 128 + ch * 8) = v; }
    }
    __syncthreads();
}
}
namespace rk {
constexpr int LD64 = 72, LD128 = 136, LDF = 68;
constexpr int M64 = 64 * LD64 * 2  , M128 = 64 * LD128 * 2  , MF = 64 * LDF * 4  ;
constexpr int R1 = 0;
constexpr int O_TXW = R1, O_XA = R1 + M64, O_SXG = R1 + 2 * M64;
constexpr int O_LAB = R1, O_LAK = R1 + M64, O_LRB = R1 + 2 * M64, O_LRK = R1 + 3 * M64;
constexpr int R2 = R1 + 4 * M64;
constexpr int O_LC = R2, O_AA = R2 + MF;
constexpr int O_TL = R2, O_YS = R2 + M64, O_X1 = R2 + 2 * M64, O_AP = R2 + 3 * M64, O_WW = R2 + 4 * M64, O_YF = R2;
constexpr int FX = R2 + 5 * M64;
constexpr int O_AT = FX, O_BT = FX + M64, O_KT = FX + 2 * M64, O_RT = FX + 3 * M64, O_VM = FX + 4 * M64, O_GG = FX + 5 * M64, O_SB = FX + 6 * M64;
constexpr int O_LABD = FX + 7 * M64;
constexpr int O_SEG = O_LABD + 4352, O_BS = O_SEG + 2048, O_PCV = O_BS + 256, O_CONST = O_PCV + 256, O_END = O_CONST + 14 * 256;
static_assert(O_END <= LDSCTL_OFF && MF <= 2 * M64 && 2 * M64 + M128 <= 4 * M64, "rwkv LDS map");
enum { C_W0 = 0, C_A0, C_KK, C_KA, C_RK, C_LNW, C_LNB, C_MUR, C_MUK, C_MUV, C_MUW, C_MUA, C_MUG   };

typedef LAS unsigned char* lptr;
__device__ __forceinline__ bf16x8 ldA(lptr base, int ld, int m0, int k0, int lane) { return *(LAS const bf16x8*)(base + ((m0 + (lane & 15)) * ld + k0 + 8 * (lane >> 4)) * 2); }
__device__ __forceinline__ s16x4 vtr(lptr p) { typedef short v4i16_t __attribute__((ext_vector_type(4))); return __builtin_bit_cast(s16x4, __builtin_amdgcn_ds_read_tr16_b64_v4i16((LAS v4i16_t*)p)); }
__device__ __forceinline__ bf16x8 ldT(lptr base, int ld, int k0, int n0, int lane) {
    const int g = lane >> 4, q = (lane & 15) >> 2, p = lane & 3;
    lptr a = base + ((k0 + 8 * g + q) * ld + n0 + 4 * p) * 2;
    const s16x4 lo = vtr(a), hi = vtr(a + 4 * ld * 2);
    return (bf16x8){lo[0], lo[1], lo[2], lo[3], hi[0], hi[1], hi[2], hi[3]};
}
#define RK_MFMA(a, b, c) __builtin_amdgcn_mfma_f32_16x16x32_bf16((a), (b), (c), 0, 0, 0)
__device__ __forceinline__ void st16(lptr base, int ld, int m0, int n0, int lane, const f32x4& v) {
    LAS bf16* p = (LAS bf16*)base + (m0 + 4 * (lane >> 4)) * ld + n0 + (lane & 15);
#pragma unroll
    for (int i = 0; i < 4; ++i) p[i * ld] = (bf16)f2bf(v[i]);
}
__device__ __forceinline__ void unpack8(const v4u& w, float* f) { f[0] = bflo(w.x); f[1] = bfhi(w.x); f[2] = bflo(w.y); f[3] = bfhi(w.y); f[4] = bflo(w.z); f[5] = bfhi(w.z); f[6] = bflo(w.w); f[7] = bfhi(w.w); }
__device__ __forceinline__ v4u pack8(const float* f) { v4u o; o.x = pk2(f[0], f[1]); o.y = pk2(f[2], f[3]); o.z = pk2(f[4], f[5]); o.w = pk2(f[6], f[7]); return o; }
__device__ __forceinline__ void ldc8(lptr lds, int cidx, int off, float* f) { const f32x4 a = *(LAS const f32x4*)(lds + O_CONST + cidx * 256 + off * 4), b = *(LAS const f32x4*)(lds + O_CONST + cidx * 256 + off * 4 + 16);
    f[0] = a.x; f[1] = a.y; f[2] = a.z; f[3] = a.w; f[4] = b.x; f[5] = b.y; f[6] = b.z; f[7] = b.w; }

struct Params { const bf16* PR; bf16* RO; const float* mu; const float* w0; const float* a0; const float* kk; const float* ka; const float* rk; const float* lnw; const float* lnb; const bf16* W2T; const bf16* A2T; const bf16* G2T; };

__device__ __forceinline__ void run(lptr lds, const Params& P, int b, int h) {
    int tid = threadIdx.x, lane, wid, et, oct, g4, l15, mt, nt0;
#define RK_STAGE() do { asm volatile("" : "+v"(tid)); lane = tid & 63; wid = __builtin_amdgcn_readfirstlane(tid >> 6); et = tid >> 3; oct = tid & 7; g4 = lane >> 4; l15 = lane & 15; mt = wid >> 1; nt0 = 2 * (wid & 1); } while (0)
    RK_STAGE();
    if (tid < 64) { LAS float* C = (LAS float*)(lds + O_CONST); const int n = h * 64 + tid;
        C[C_W0 * 64 + tid] = P.w0[n]; C[C_A0 * 64 + tid] = P.a0[n]; C[C_KK * 64 + tid] = P.kk[n]; C[C_KA * 64 + tid] = P.ka[n]; C[C_RK * 64 + tid] = P.rk[n]; C[C_LNW * 64 + tid] = P.lnw[n]; C[C_LNB * 64 + tid] = P.lnb[n];
        C[C_MUR * 64 + tid] = P.mu[n]; C[C_MUK * 64 + tid] = P.mu[1024 + n]; C[C_MUV * 64 + tid] = P.mu[2048 + n]; C[C_MUW * 64 + tid] = P.mu[3072 + tid]; C[C_MUA * 64 + tid] = P.mu[3136 + tid];
        C[C_MUG * 64 + tid] = P.mu[3200 + tid]; C[C_MUG * 64 + 64 + tid] = P.mu[3264 + tid]; }
    for (int i = tid; i < M64 / 4; i += NTHREADS) ((LAS unsigned*)(lds + O_SB))[i] = 0u;
    bf16x8 wf[4];
    if (wid < 4) { const int n = h * 64 + 16 * wid + l15;
#pragma unroll
        for (int ks = 0; ks < 2; ++ks) { wf[ks] = *(const GAS bf16x8*)(P.W2T + (size_t)n * 64 + 32 * ks + 8 * g4); wf[2 + ks] = *(const GAS bf16x8*)(P.A2T + (size_t)n * 64 + 32 * ks + 8 * g4); } }
    else { const int n = h * 64 + 16 * (wid - 4) + l15;
#pragma unroll
        for (int ks = 0; ks < 4; ++ks) wf[ks] = *(const GAS bf16x8*)(P.G2T + (size_t)n * 128 + 32 * ks + 8 * g4); }
    f32x4 s0 = {0.f, 0.f, 0.f, 0.f}, s1 = {0.f, 0.f, 0.f, 0.f};
    __syncthreads();
    for (int c = 0; c <= 32; ++c) {
        RK_STAGE();
        const bool valid = (c > 0) || (et < NMETA);
        const int rowc = (c == 0) ? (MX + et) : (b * SEQ + 64 * (c - 1) + et);
        const bool hasprev = !(c == 0 && et == 0);
        const int rowp = (c == 1 && et == 0) ? (MX + NMETA - 1) : rowc - 1;
        float rr[8], kr[8], vr[8];
        {
            const bf16* pc = P.PR + (size_t)rowc * RW_COLS; const bf16* pp = P.PR + (size_t)rowp * RW_COLS;
            const v4u z4 = {0u, 0u, 0u, 0u};
#define RK_LERP(dst, colofs, cidx, coff) do { float cu[8], pv[8], mm[8]; unpack8(valid ? *(const GAS v4u*)(pc + (colofs)) : z4, cu); unpack8((valid && hasprev) ? *(const GAS v4u*)(pp + (colofs)) : z4, pv); ldc8(lds, cidx, coff, mm); \
            _Pragma("unroll") for (int j = 0; j < 8; ++j) dst[j] = cu[j] + (pv[j] - cu[j]) * mm[j]; } while (0)
            RK_LERP(rr, h * 64 + 8 * oct, C_MUR, 8 * oct); RK_LERP(kr, 1024 + h * 64 + 8 * oct, C_MUK, 8 * oct); RK_LERP(vr, 2048 + h * 64 + 8 * oct, C_MUV, 8 * oct);
            float xw[8], xa[8], xg0[8], xg1[8];
            RK_LERP(xw, 3072 + 8 * oct, C_MUW, 8 * oct); RK_LERP(xa, 3136 + 8 * oct, C_MUA, 8 * oct); RK_LERP(xg0, 3200 + 16 * oct, C_MUG, 16 * oct); RK_LERP(xg1, 3208 + 16 * oct, C_MUG, 16 * oct + 8);
#undef RK_LERP
#pragma unroll
            for (int j = 0; j < 8; ++j) { xw[j] = 1.0f - 2.0f / (1.0f + __expf(2.0f * xw[j])); xg0[j] = 1.0f / (1.0f + __expf(-xg0[j])); xg1[j] = 1.0f / (1.0f + __expf(-xg1[j])); }
            *(LAS v4u*)(lds + O_TXW + (et * LD64 + 8 * oct) * 2) = pack8(xw);
            *(LAS v4u*)(lds + O_XA + (et * LD64 + 8 * oct) * 2) = pack8(xa);
            *(LAS v4u*)(lds + O_SXG + (et * LD128 + 16 * oct) * 2) = pack8(xg0);
            *(LAS v4u*)(lds + O_SXG + (et * LD128 + 16 * oct + 8) * 2) = pack8(xg1);
        }
        __syncthreads();
        RK_STAGE();
        if (wid < 4) {
            const int k = 16 * wid + l15; const float w0k = ((LAS const float*)(lds + O_CONST))[C_W0 * 64 + k], a0k = ((LAS const float*)(lds + O_CONST))[C_A0 * 64 + k];
#pragma unroll
            for (int m = 0; m < 4; ++m) {
                f32x4 aw = {0.f, 0.f, 0.f, 0.f}, aa = {0.f, 0.f, 0.f, 0.f};
#pragma unroll
                for (int ks = 0; ks < 2; ++ks) { aw = RK_MFMA(ldA(lds + O_TXW, LD64, 16 * m, 32 * ks, lane), wf[ks], aw); aa = RK_MFMA(ldA(lds + O_XA, LD64, 16 * m, 32 * ks, lane), wf[2 + ks], aa); }
#pragma unroll
                for (int i = 0; i < 4; ++i) { const int t = 16 * m + 4 * g4 + i;
                    const float wl = w0k + aw[i]; const float sp = (wl > 15.f) ? __expf(-wl) : log1pf(__expf(-wl));
                    float ld = -__expf(-sp - 0.5f); if (c == 0 && t >= NMETA) ld = 0.f;
                    ((LAS float*)(lds + O_LC))[t * LDF + k] = ld;
                    ((LAS bf16*)(lds + O_AA))[t * LD64 + k] = (bf16)f2bf(1.0f / (1.0f + __expf(-(a0k + aa[i])))); }
            }
        } else {
            const int n0 = 16 * (wid - 4);
#pragma unroll
            for (int m = 0; m < 4; ++m) { f32x4 ag = {0.f, 0.f, 0.f, 0.f};
#pragma unroll
                for (int ks = 0; ks < 4; ++ks) ag = RK_MFMA(ldA(lds + O_SXG, LD128, 16 * m, 32 * ks, lane), wf[ks], ag);
                st16(lds + O_GG, LD64, 16 * m, n0, lane, ag); }
        }
        __syncthreads();
        RK_STAGE();
        { const int k = tid & 63, seg = tid >> 6; LAS float* LC = (LAS float*)(lds + O_LC); float run = 0.f;
#pragma unroll
          for (int j = 0; j < 8; ++j) { run += LC[(8 * seg + j) * LDF + k]; LC[(8 * seg + j) * LDF + k] = run; }
          ((LAS float*)(lds + O_SEG))[seg * 64 + k] = run;
          __syncthreads();
          float off = 0.f;
          for (int s2 = 0; s2 < seg; ++s2) off += ((LAS const float*)(lds + O_SEG))[s2 * 64 + k];
#pragma unroll
          for (int j = 0; j < 8; ++j) LC[(8 * seg + j) * LDF + k] += off; }
        __syncthreads();
        RK_STAGE();
        {
            float lc[8], lp[8], aa[8], ck[8];
            { const f32x4 a = *(LAS const f32x4*)(lds + O_LC + (et * LDF + 8 * oct) * 4), b2 = *(LAS const f32x4*)(lds + O_LC + (et * LDF + 8 * oct) * 4 + 16);
              lc[0] = a.x; lc[1] = a.y; lc[2] = a.z; lc[3] = a.w; lc[4] = b2.x; lc[5] = b2.y; lc[6] = b2.z; lc[7] = b2.w; }
            if (et > 0) { const f32x4 a = *(LAS const f32x4*)(lds + O_LC + ((et - 1) * LDF + 8 * oct) * 4), b2 = *(LAS const f32x4*)(lds + O_LC + ((et - 1) * LDF + 8 * oct) * 4 + 16);
              lp[0] = a.x; lp[1] = a.y; lp[2] = a.z; lp[3] = a.w; lp[4] = b2.x; lp[5] = b2.y; lp[6] = b2.z; lp[7] = b2.w; }
            else {
#pragma unroll
              for (int j = 0; j < 8; ++j) lp[j] = 0.f; }
            { const v4u t_ = *(LAS const v4u*)(lds + O_AA + (et * LD64 + 8 * oct) * 2); unpack8(t_, aa); }
            ldc8(lds, C_KK, 8 * oct, ck);
            float kk[8], ss = 0.f;
#pragma unroll
            for (int j = 0; j < 8; ++j) { kk[j] = kr[j] * ck[j]; ss += kk[j] * kk[j]; }
            ss += __shfl_xor(ss, 1); ss += __shfl_xor(ss, 2); ss += __shfl_xor(ss, 4);
            const float rn = 1.0f / fmaxf(sqrtf(ss), 1e-12f);
            ldc8(lds, C_KA, 8 * oct, ck);
            float kp[8], at[8], bt[8], kt[8], rt[8];
#pragma unroll
            for (int j = 0; j < 8; ++j) { kk[j] *= rn; kp[j] = kr[j] * (1.0f + (aa[j] - 1.0f) * ck[j]);
                const float eP = __expf(lp[j]), eN = __expf(-lc[j]), eC = __expf(lc[j]);
                at[j] = -kk[j] * eP; bt[j] = kk[j] * aa[j] * eN; kt[j] = kp[j] * eN; rt[j] = rr[j] * eC;
                if (et == 63) ((LAS float*)(lds + O_PCV))[8 * oct + j] = eC; }
            ldc8(lds, C_RK, 8 * oct, ck);
            float bsum = 0.f;
#pragma unroll
            for (int j = 0; j < 8; ++j) bsum += rr[j] * kp[j] * ck[j];
            bsum += __shfl_xor(bsum, 1); bsum += __shfl_xor(bsum, 2); bsum += __shfl_xor(bsum, 4);
            if (oct == 0) ((LAS float*)(lds + O_BS))[et] = bsum;
            *(LAS v4u*)(lds + O_AT + (et * LD64 + 8 * oct) * 2) = pack8(at);
            *(LAS v4u*)(lds + O_BT + (et * LD64 + 8 * oct) * 2) = pack8(bt);
            *(LAS v4u*)(lds + O_KT + (et * LD64 + 8 * oct) * 2) = pack8(kt);
            *(LAS v4u*)(lds + O_RT + (et * LD64 + 8 * oct) * 2) = pack8(rt);
            *(LAS v4u*)(lds + O_VM + (et * LD64 + 8 * oct) * 2) = pack8(vr);
        }
        __syncthreads();
        RK_STAGE();
        { const v4u z4 = {0u, 0u, 0u, 0u}; for (int i = tid; i < 2 * M64 / 16; i += NTHREADS) *(LAS v4u*)(lds + O_TL + i * 16) = z4; }
        {
#pragma unroll
            for (int q = 0; q < 2; ++q) { const int nt = nt0 + q;
                f32x4 cab = {0.f, 0.f, 0.f, 0.f}, cak = cab, crb = cab, crk = cab;
                if (nt <= mt) {
#pragma unroll
                    for (int ks = 0; ks < 2; ++ks) { const bf16x8 fa = ldA(lds + O_AT, LD64, 16 * mt, 32 * ks, lane), fr = ldA(lds + O_RT, LD64, 16 * mt, 32 * ks, lane), fb = ldA(lds + O_BT, LD64, 16 * nt, 32 * ks, lane), fk = ldA(lds + O_KT, LD64, 16 * nt, 32 * ks, lane);
                        cab = RK_MFMA(fa, fb, cab); cak = RK_MFMA(fa, fk, cak); crb = RK_MFMA(fr, fb, crb); crk = RK_MFMA(fr, fk, crk); }
#pragma unroll
                    for (int i = 0; i < 4; ++i) { const int t = 16 * mt + 4 * g4 + i, ii = 16 * nt + l15; if (!(t > ii)) { cab[i] = 0.f; cak[i] = 0.f; } if (!(t >= ii)) { crb[i] = 0.f; crk[i] = 0.f; } }
                    if (nt == mt) {
#pragma unroll
                        for (int i = 0; i < 4; ++i) ((LAS float*)(lds + O_LABD))[(mt * 16 + 4 * g4 + i) * 17 + l15] = cab[i]; }
                }
                st16(lds + O_LAB, LD64, 16 * mt, 16 * nt, lane, cab); st16(lds + O_LAK, LD64, 16 * mt, 16 * nt, lane, cak); st16(lds + O_LRB, LD64, 16 * mt, 16 * nt, lane, crb); st16(lds + O_LRK, LD64, 16 * mt, 16 * nt, lane, crk); }
        }
        __syncthreads();
        RK_STAGE();
        if (wid == 0) {
            { const int blk = g4, cc = l15; LAS const float* Lb = (LAS const float*)(lds + O_LABD) + blk * 16 * 17; float T[16];
#pragma unroll
              for (int r = 0; r < 16; ++r) { float acc = (r == cc) ? 1.f : 0.f;
#pragma unroll
                  for (int j = 0; j < r; ++j) acc += Lb[r * 17 + j] * T[j];
                  T[r] = acc; }
#pragma unroll
              for (int r = 0; r < 16; ++r) ((LAS bf16*)(lds + O_TL))[(16 * blk + r) * LD64 + 16 * blk + cc] = (bf16)f2bf(T[r]); }
            asm volatile("s_waitcnt lgkmcnt(0)" ::: "memory");
            const f32x4 z = {0.f, 0.f, 0.f, 0.f};
#pragma unroll
            for (int pp = 0; pp < 2; ++pp) { const f32x4 y1 = RK_MFMA(ldA(lds + O_LAB, LD64, 32 * pp + 16, 32 * pp, lane), ldT(lds + O_TL, LD64, 32 * pp, 32 * pp, lane), z); st16(lds + O_YS, LD64, 32 * pp + 16, 32 * pp, lane, y1); }
            asm volatile("s_waitcnt lgkmcnt(0)" ::: "memory");
            f32x4 t21[2];
#pragma unroll
            for (int pp = 0; pp < 2; ++pp) t21[pp] = RK_MFMA(ldA(lds + O_TL, LD64, 32 * pp + 16, 32 * pp, lane), ldT(lds + O_YS, LD64, 32 * pp, 32 * pp, lane), z);
            asm volatile("s_waitcnt lgkmcnt(0)" ::: "memory");
#pragma unroll
            for (int pp = 0; pp < 2; ++pp) st16(lds + O_TL, LD64, 32 * pp + 16, 32 * pp, lane, t21[pp]);
            asm volatile("s_waitcnt lgkmcnt(0)" ::: "memory");
#pragma unroll
            for (int a = 0; a < 2; ++a)
#pragma unroll
                for (int bq = 0; bq < 2; ++bq) { const f32x4 y2 = RK_MFMA(ldA(lds + O_LAB, LD64, 32 + 16 * a, 0, lane), ldT(lds + O_TL, LD64, 0, 16 * bq, lane), z); st16(lds + O_YS, LD64, 32 + 16 * a, 16 * bq, lane, y2); }
            asm volatile("s_waitcnt lgkmcnt(0)" ::: "memory");
            f32x4 t2[2][2];
#pragma unroll
            for (int a = 0; a < 2; ++a)
#pragma unroll
                for (int bq = 0; bq < 2; ++bq) t2[a][bq] = RK_MFMA(ldA(lds + O_TL, LD64, 32 + 16 * a, 32, lane), ldT(lds + O_YS, LD64, 32, 16 * bq, lane), z);
            asm volatile("s_waitcnt lgkmcnt(0)" ::: "memory");
#pragma unroll
            for (int a = 0; a < 2; ++a)
#pragma unroll
                for (int bq = 0; bq < 2; ++bq) st16(lds + O_TL, LD64, 32 + 16 * a, 16 * bq, lane, t2[a][bq]);
        } else {
            for (int q = wid - 1; q < 16; q += 7) { const int m = q >> 2, n = q & 3; f32x4 acc = {0.f, 0.f, 0.f, 0.f};
#pragma unroll
                for (int ks = 0; ks < 2; ++ks) acc = RK_MFMA(ldA(lds + O_LAK, LD64, 16 * m, 32 * ks, lane), ldT(lds + O_VM, LD64, 32 * ks, 16 * n, lane), acc);
                st16(lds + O_X1, LD64, 16 * m, 16 * n, lane, acc); }
        }
        __syncthreads();
        RK_STAGE();
        f32x4 wl[2];
        {
            bf16x8 ft[2]; ft[0] = ldA(lds + O_TL, LD64, 16 * mt, 0, lane); ft[1] = ldA(lds + O_TL, LD64, 16 * mt, 32, lane);
#pragma unroll
            for (int q = 0; q < 2; ++q) { const int nt = nt0 + q; f32x4 ap = {0.f, 0.f, 0.f, 0.f}; wl[q] = ap;
#pragma unroll
                for (int ks = 0; ks < 2; ++ks) { ap = RK_MFMA(ft[ks], ldT(lds + O_AT, LD64, 32 * ks, 16 * nt, lane), ap); wl[q] = RK_MFMA(ft[ks], ldT(lds + O_X1, LD64, 32 * ks, 16 * nt, lane), wl[q]); }
                st16(lds + O_AP, LD64, 16 * mt, 16 * nt, lane, ap); }
        }
        __syncthreads();
        RK_STAGE();
        {
#pragma unroll
            for (int q = 0; q < 2; ++q) { const int nt = nt0 + q;
#pragma unroll
                for (int ks = 0; ks < 2; ++ks) wl[q] = RK_MFMA(ldA(lds + O_AP, LD64, 16 * mt, 32 * ks, lane), ldA(lds + O_SB, LD64, 16 * nt, 32 * ks, lane), wl[q]);
                st16(lds + O_WW, LD64, 16 * mt, 16 * nt, lane, wl[q]); }
        }
        __syncthreads();
        RK_STAGE();
        {
#pragma unroll
            for (int q = 0; q < 2; ++q) { const int nt = nt0 + q; f32x4 y = {0.f, 0.f, 0.f, 0.f};
#pragma unroll
                for (int ks = 0; ks < 2; ++ks) { y = RK_MFMA(ldA(lds + O_RT, LD64, 16 * mt, 32 * ks, lane), ldA(lds + O_SB, LD64, 16 * nt, 32 * ks, lane), y);
                    y = RK_MFMA(ldA(lds + O_LRK, LD64, 16 * mt, 32 * ks, lane), ldT(lds + O_VM, LD64, 32 * ks, 16 * nt, lane), y);
                    y = RK_MFMA(ldA(lds + O_LRB, LD64, 16 * mt, 32 * ks, lane), ldT(lds + O_WW, LD64, 32 * ks, 16 * nt, lane), y); }
                wl[q] = y; }
            f32x4 d0 = {0.f, 0.f, 0.f, 0.f}, d1 = d0;
#pragma unroll
            for (int ks = 0; ks < 2; ++ks) { const bf16x8 fw = ldT(lds + O_WW, LD64, 32 * ks, 16 * mt, lane), fv = ldT(lds + O_VM, LD64, 32 * ks, 16 * mt, lane);
                d0 = RK_MFMA(fw, ldT(lds + O_BT, LD64, 32 * ks, 16 * nt0, lane), d0); d0 = RK_MFMA(fv, ldT(lds + O_KT, LD64, 32 * ks, 16 * nt0, lane), d0);
                d1 = RK_MFMA(fw, ldT(lds + O_BT, LD64, 32 * ks, 16 * nt0 + 16, lane), d1); d1 = RK_MFMA(fv, ldT(lds + O_KT, LD64, 32 * ks, 16 * nt0 + 16, lane), d1); }
            const float pc0 = ((LAS const float*)(lds + O_PCV))[16 * nt0 + l15], pc1 = ((LAS const float*)(lds + O_PCV))[16 * nt0 + 16 + l15];
            s0 = (s0 + d0) * pc0; s1 = (s1 + d1) * pc1;
        }
        __syncthreads(); RK_STAGE();
        {
#pragma unroll
            for (int q = 0; q < 2; ++q) { LAS float* yp = (LAS float*)(lds + O_YF) + (16 * mt + 4 * g4) * LDF + 16 * (nt0 + q) + l15;
#pragma unroll
                for (int i = 0; i < 4; ++i) yp[i * LDF] = wl[q][i]; }
            st16(lds + O_SB, LD64, 16 * mt, 16 * nt0, lane, s0); st16(lds + O_SB, LD64, 16 * mt, 16 * nt0 + 16, lane, s1);
        }
        __syncthreads();
        RK_STAGE();
        if (c > 0) {
            float y[8], gg[8], lw[8], lb[8];
            { const f32x4 a = *(LAS const f32x4*)(lds + O_YF + (et * LDF + 8 * oct) * 4), b2 = *(LAS const f32x4*)(lds + O_YF + (et * LDF + 8 * oct) * 4 + 16);
              y[0] = a.x; y[1] = a.y; y[2] = a.z; y[3] = a.w; y[4] = b2.x; y[5] = b2.y; y[6] = b2.z; y[7] = b2.w; }
            float sm = 0.f;
#pragma unroll
            for (int j = 0; j < 8; ++j) sm += y[j];
            sm += __shfl_xor(sm, 1); sm += __shfl_xor(sm, 2); sm += __shfl_xor(sm, 4);
            const float mean = sm * (1.f / 64.f); float sv = 0.f;
#pragma unroll
            for (int j = 0; j < 8; ++j) { y[j] -= mean; sv += y[j] * y[j]; }
            sv += __shfl_xor(sv, 1); sv += __shfl_xor(sv, 2); sv += __shfl_xor(sv, 4);
            const float rstd = 1.0f / sqrtf(sv * (1.f / 64.f) + 64e-5f);
            { const v4u t_ = *(LAS const v4u*)(lds + O_GG + (et * LD64 + 8 * oct) * 2); unpack8(t_, gg); } ldc8(lds, C_LNW, 8 * oct, lw); ldc8(lds, C_LNB, 8 * oct, lb);
            const float bsv = ((LAS const float*)(lds + O_BS))[et];
            float o[8];
#pragma unroll
            for (int j = 0; j < 8; ++j) o[j] = (y[j] * rstd * lw[j] + lb[j] + bsv * vr[j]) * gg[j];
            *(GAS v4u*)(P.RO + (size_t)rowc * D + h * 64 + 8 * oct) = pack8(o);
        }
        __syncthreads();
    }
}
#undef RK_STAGE
}
constexpr int MOE_CAP = 40960, MOE_MAXT = 160;
constexpr int RW_CNT = CW_ROUTE, RW_CUR = CW_ROUTE + 64, RW_NT = CW_ROUTE + 128, RW_TE = CW_ROUTE + 192  ;
constexpr int RW_TOKK = 65536  , RW_GATE = RW_TOKK + MOE_CAP  ;
static_assert((RW_GATE + MOE_CAP) * 4 <= (int)CTL_ZERO_BYTES, "route tables inside CTL");
constexpr size_t WS_TE = WS_SMALL + 512 * 1024, WS_TG = WS_TE + 128 * 1024;

__device__ __forceinline__ void moe_row(const float* h2row, const float* n2w, bf16* xrow, const float* wg, const float* bg, const float* we, const float* be, int* te, float* tg, int m, LAS unsigned* hist, int lane) {
    const GAS f32x4* xr = (const GAS f32x4*)h2row + lane; const GAS f32x4* wr = (const GAS f32x4*)n2w + lane;
    f32x4 v[4]; float s2 = 0.f;
#pragma unroll
    for (int j = 0; j < 4; ++j) { v[j] = xr[64 * j]; s2 += (v[j].x * v[j].x + v[j].y * v[j].y) + (v[j].z * v[j].z + v[j].w * v[j].w); }
    const float rstd = 1.f / sqrtf(wave_sum(s2) * (1.f / D) + NORM_EPS);
    GAS unsigned long long* o8 = (GAS unsigned long long*)xrow + lane;
#pragma unroll
    for (int j = 0; j < 4; ++j) { const f32x4 g = wr[64 * j]; v[j] = v[j] * rstd * g;
        o8[64 * j] = (unsigned long long)pk2(v[j].x, v[j].y) | ((unsigned long long)pk2(v[j].z, v[j].w) << 32); }
    float lg[4] = {0.f, 0.f, 0.f, 0.f};
#pragma unroll
    for (int j = 0; j < 4; ++j)
#pragma unroll
        for (int i = 0; i < 4; ++i) { const int k = 4 * (lane + 64 * j) + i; const f32x4 w4 = *(const GAS f32x4*)(wg + (size_t)k * 4); const float u = v[j][i];
            lg[0] += u * w4.x; lg[1] += u * w4.y; lg[2] += u * w4.z; lg[3] += u * w4.w; }
#pragma unroll
    for (int q = 0; q < 4; ++q) lg[q] = wave_sum(lg[q]) + bg[q];
    int gi = 0; float gm = lg[0];
#pragma unroll
    for (int q = 1; q < 4; ++q) if (lg[q] > gm) { gm = lg[q]; gi = q; }
    float gs = 0.f;
#pragma unroll
    for (int q = 0; q < 4; ++q) gs += __expf(lg[q] - gm);
    const float gval = 1.0f / gs;
    float le[8];
#pragma unroll
    for (int q = 0; q < 8; ++q) le[q] = 0.f;
#pragma unroll
    for (int j = 0; j < 4; ++j)
#pragma unroll
        for (int i = 0; i < 4; ++i) { const int k = 4 * (lane + 64 * j) + i; const GAS f32x4* wp = (const GAS f32x4*)(we + (size_t)k * 32 + gi * 8); const f32x4 a = wp[0], b = wp[1]; const float u = v[j][i];
            le[0] += u * a.x; le[1] += u * a.y; le[2] += u * a.z; le[3] += u * a.w; le[4] += u * b.x; le[5] += u * b.y; le[6] += u * b.z; le[7] += u * b.w; }
#pragma unroll
    for (int q = 0; q < 8; ++q) le[q] = wave_sum(le[q]) + be[gi * 8 + q];
    int i1 = 0; float m1 = le[0];
#pragma unroll
    for (int q = 1; q < 8; ++q) if (le[q] > m1) { m1 = le[q]; i1 = q; }
    int i2 = -1; float m2 = -INFINITY;
#pragma unroll
    for (int q = 0; q < 8; ++q) if (q != i1 && le[q] > m2) { m2 = le[q]; i2 = q; }
    const float p2 = __expf(m2 - m1), inv = 1.0f / (1.0f + p2);
    if (lane == 0) { te[2 * m] = gi * 8 + i1; te[2 * m + 1] = gi * 8 + i2; tg[2 * m] = gval * inv; tg[2 * m + 1] = gval * p2 * inv;
        __hip_atomic_fetch_add(hist + gi * 8 + i1, 1u, __ATOMIC_RELAXED, __HIP_MEMORY_SCOPE_WORKGROUP); __hip_atomic_fetch_add(hist + gi * 8 + i2, 1u, __ATOMIC_RELAXED, __HIP_MEMORY_SCOPE_WORKGROUP); }
}

namespace pg8 {
struct LinearAOrder {
    StaticOrder so; unsigned rowbytes;
    __device__ bool next(int i, Unit& u) const { return so.next(i, u); }
    __device__ __forceinline__ unsigned a_row_off(const Unit& u, int r) const { return (unsigned)(u.pm * BM + r) * rowbytes; }
};
struct MoeOrder {
    const int* tokk; const unsigned* tile_e; int ntile, G, c; bool gather; unsigned rowbytes;
    __device__ bool next(int i, Unit& u) const { const long L = (long)i * G + c; if (L >= 4L * ntile) return false; const int tile = (int)(L >> 2); u.pm = tile; u.pn = (int)tile_e[tile] * 4 + (int)(L & 3); return true; }
    __device__ __forceinline__ unsigned a_row_off(const Unit& u, int r) const {
        if (gather) { const int idx = tokk[u.pm * BM + r]; const int tok = idx < 0 ? MX : (idx >> 1); return (unsigned)tok * rowbytes; }
        return (unsigned)(u.pm * BM + r) * rowbytes; }
};
struct EpiSwiGLU {
    static constexpr bool PERM = true, AFTER_DRAIN = false;
    bf16_t* H;
    __device__ __forceinline__ void operator()(const f32x4 (&acc)[2][2][4][2], const Unit& u, int wr, int wc, int fr, int fq) const {
        const int row0 = u.pm * BM + wr * 64 + fr, col0 = (u.pn & 3) * 128 + wc * 32 + 8 * fq;
#pragma unroll
        for (int ai = 0; ai < 2; ++ai)
#pragma unroll
            for (int m = 0; m < 4; ++m) { const size_t row = row0 + ai * HALF + m * 16; f32x4 h0, h1;
#pragma unroll
                for (int e = 0; e < 4; ++e) { const float g0 = acc[ai][0][m][0][e], g1 = acc[ai][0][m][1][e];
                    h0[e] = g0 / (1.0f + __expf(-g0)) * acc[ai][1][m][0][e]; h1[e] = g1 / (1.0f + __expf(-g1)) * acc[ai][1][m][1][e]; }
                u32x4 w; w.x = cvt_pk_bf16(h0[0], h0[1]); w.y = cvt_pk_bf16(h0[2], h0[3]); w.z = cvt_pk_bf16(h1[0], h1[1]); w.w = cvt_pk_bf16(h1[2], h1[3]);
                *(u32x4*)(H + row * 512 + col0) = w; }
    }
};
struct EpiMoeDown {
    static constexpr bool PERM = false, AFTER_DRAIN = false;
    const int* tokk; const float* gate; float* O; bf16_t* Y1;
    __device__ __forceinline__ void operator()(const f32x4 (&acc)[2][2][4][2], const Unit& u, int wr, int wc, int fr, int fq) const {
        const int slot0 = u.pm * BM + wr * 64 + fr, col0 = (u.pn & 3) * BM + wc * 32 + 4 * fq;
#pragma unroll
        for (int ai = 0; ai < 2; ++ai)
#pragma unroll
            for (int m = 0; m < 4; ++m) { const int slot = slot0 + ai * HALF + m * 16; const int tk = tokk[slot];
                if (tk >= 0) { const float gt = gate[slot]; const size_t off = (size_t)(tk >> 1) * 1024 + col0;
                    if ((tk & 1) == 0) {
#pragma unroll
                        for (int bj = 0; bj < 2; ++bj)
#pragma unroll
                            for (int n = 0; n < 2; ++n) { f32x4* p = (f32x4*)(O + off + bj * HALF + n * 16); *p = *p + acc[ai][bj][m][n] * gt; }
                    } else {
#pragma unroll
                        for (int bj = 0; bj < 2; ++bj)
#pragma unroll
                            for (int n = 0; n < 2; ++n) { const f32x4 v = acc[ai][bj][m][n] * gt; unsigned long long w = (unsigned long long)cvt_pk_bf16(v[0], v[1]) | ((unsigned long long)cvt_pk_bf16(v[2], v[3]) << 32);
                                *(unsigned long long*)(Y1 + off + bj * HALF + n * 16) = w; }
                    } } }
    }
};
}
struct Args { const float* in[33]; float* out; unsigned char* ws; int pad0, pad1; };
__global__ void __launch_bounds__(NTHREADS, 2) fwd_kernel(Args args) {
    extern __shared__ __attribute__((aligned(16))) unsigned char lds_raw[];
    LAS unsigned char* lds = (LAS unsigned char*)lds_raw;
    volatile LAS unsigned* MISC = (volatile LAS unsigned*)(lds + MISC_OFF);
    const int tid = threadIdx.x, lane = tid & 63, wave = __builtin_amdgcn_readfirstlane(tid >> 6);
    const int G = gridDim.x, bx = blockIdx.x; const int vcu = (G % 8 == 0) ? (bx % 8) * (G / 8) + bx / 8 : bx;
    unsigned char* ws = args.ws; gu32* ctl = (gu32*)(ws + WS_CTL);
    for (int u = tid; u < (LDS_BYTES - LDSCTL_OFF) / 4; u += NTHREADS) ((LAS unsigned*)(lds + LDSCTL_OFF))[u] = 0u;
    __syncthreads();
    XcdBarrier bar = xcd_barrier_post((unsigned*)(ctl + CW_BAR), MISC + 8);
    const float* x = args.in[0]; float* out = args.out;
    bf16* U = (bf16*)out;
    bf16* WinT = (bf16*)(ws + WS_WIN);
    bf16* PR = (bf16*)(ws + WS_PR); bf16* PD = (bf16*)(ws + WS_PD); bf16* PG = (bf16*)(ws + WS_PG);
    const int gw = vcu * NWAVES + wave, NGW = G * NWAVES;

    {
        LAS float* scr = (LAS float*)(lds + wave * 16384);
        const float* Win = args.in[3];
        constexpr int I_IN = (D / 64) * (IN_COLS / 32);
        for (int it = gw; it < I_IN; it += NGW) { const int nblk = IN_COLS / 32, kb = it / nblk, nb = it % nblk; transpose_item(Win, IN_COLS, WinT, D, 32 * nb, 64 * kb, 32 * nb, scr, lane); }
        { const float* Ws[3] = {args.in[22], args.in[23], args.in[24]}; bf16* Wd[3] = {(bf16*)(ws + WS_WBR), (bf16*)(ws + WS_WBD), (bf16*)(ws + WS_WOUT)};
          constexpr int I_SQ = (D / 64) * (D / 32);
#pragma unroll
          for (int w = 0; w < 3; ++w) for (int it = gw; it < I_SQ; it += NGW) { const int kb = it / 32, nb = it % 32; transpose_item(Ws[w], D, Wd[w], D, 32 * nb, 64 * kb, 32 * nb, scr, lane); } }
        { bf16* W2T = (bf16*)(ws + WS_SMALL); bf16* A2T = W2T + 1024 * 64; bf16* G2T = A2T + 1024 * 64;
          for (int it = gw; it < 128; it += NGW) { const int nb = it & 31, wsel = it >> 5;
              if (wsel == 0) transpose_item(args.in[6], 1024, W2T, 64, 32 * nb, 0, 32 * nb, scr, lane);
              else if (wsel == 1) transpose_item(args.in[8], 1024, A2T, 64, 32 * nb, 0, 32 * nb, scr, lane);
              else transpose_item(args.in[9], 1024, G2T, 128, 32 * nb, 64 * (wsel - 2), 32 * nb, scr, lane); } }
        const float* n1w = args.in[2];
        for (int m = gw; m < MPAD; m += NGW) {
            if (m < MX) rms_row_to_bf16(x + (size_t)m * D, n1w, U + (size_t)m * D, lane);
            else if (m < MROWS) rms_row_to_bf16(args.in[1] + (size_t)(m - MX) * D, n1w, U + (size_t)m * D, lane);
            else { GAS unsigned long long* o8 = (GAS unsigned long long*)(U + (size_t)m * D) + lane;
#pragma unroll
                for (int j = 0; j < 4; ++j) o8[64 * j] = 0ull; }
        }
    }
    xcd_barrier(bar);
    {
        pg8::Gemm g{U, WinT, MPAD, IN_COLS, D}; pg8::InProjOrder S; S.init(G, bx);
        pg8::EpiInProj E{PR, PD, PG};
        pg8::gemm_phase<pg8::EpiInProj, pg8::InProjOrder, true, true>(lds, g, S, E);
    }
    xcd_barrier(bar);
    {
        const float* qnw = args.in[15]; const float* knw = args.in[16];
        for (int m = gw; m < MROWS; m += NGW) { const int pos = m < MX ? NMETA + (m & (SEQ - 1)) : m - MX; qk_prepass_row(PD + (size_t)m * DF_COLS, pos, m < MX, qnw, knw, lane); }
    }
    xcd_barrier(bar);
    bf16* RO = (bf16*)out;
    bf16* DO = (bf16*)out + (size_t)MX * D;
    {
        if (vcu < 128) {
            rk::Params RP{PR, RO, args.in[4], args.in[5], args.in[7], args.in[10], args.in[11], args.in[12], args.in[13], args.in[14], (const bf16*)(ws + WS_SMALL), (const bf16*)(ws + WS_SMALL) + 1024 * 64, (const bf16*)(ws + WS_SMALL) + 2 * 1024 * 64};
            rk::run(lds, RP, vcu >> 4, vcu & 15);
        }
        float lam;
        { const float a1 = args.in[17][lane] * args.in[18][lane], a2 = args.in[19][lane] * args.in[20][lane]; lam = expf(wave_sum(a1)) - expf(wave_sum(a2)) + 0.2f; }
        for (;;) {
            if (tid == 0) MISC[0] = __hip_atomic_fetch_add(ctl + CW_QUEUE, 1u, RLX_AGENT);
            __syncthreads();
            const int idx = (int)MISC[0];
            __syncthreads();
            if (idx >= 1024) break;
            const int qb = 15 - (idx >> 6), bh = idx & 63;
            att::unit(lds, PD, DO, bh >> 3, bh & 7, qb, lam, args.in[21]);
        }
    }
    xcd_barrier(bar);
    bf16* MRG = (bf16*)(ws + WS_MRG);
    bf16* T1 = (bf16*)(ws + WS_HID);
    {
        pg8::Gemm g{RO, (const bf16*)(ws + WS_WBR), MX, D, D}; pg8::StaticOrder S; S.init(MX, D, G, bx);
        pg8::EpiGate E{PG, 0, nullptr, T1};
        pg8::gemm_phase<pg8::EpiGate, pg8::StaticOrder, true, true>(lds, g, S, E);
    }
    xcd_barrier(bar);
    {
        pg8::Gemm g{DO, (const bf16*)(ws + WS_WBD), MX, D, D}; pg8::StaticOrder S; S.init(MX, D, G, bx);
        pg8::EpiGate E{PG, 1024, T1, MRG};
        pg8::gemm_phase<pg8::EpiGate, pg8::StaticOrder, true, true>(lds, g, S, E);
    }
    xcd_barrier(bar);
    {
        pg8::Gemm g{MRG, (const bf16*)(ws + WS_WOUT), MX, D, D}; pg8::StaticOrder S; S.init(MX, D, G, bx);
        pg8::EpiResF32 E{x, out};
        pg8::gemm_phase<pg8::EpiResF32, pg8::StaticOrder, true, true>(lds, g, S, E);
    }
    xcd_barrier(bar);
    bf16* XN2 = (bf16*)(ws + WS_XN2); bf16* WGU = (bf16*)(ws + WS_WGU); bf16* WDN = (bf16*)(ws + WS_WDN); bf16* HID = (bf16*)(ws + WS_HID); bf16* Y1 = (bf16*)(ws + WS_Y1);
    int* te = (int*)(ws + WS_TE); float* tg = (float*)(ws + WS_TG);
    int* tokk = (int*)(ws + WS_CTL) + RW_TOKK; float* rgate = (float*)(ws + WS_CTL) + RW_GATE;
    {
        LAS unsigned* hist = (LAS unsigned*)(lds + 131072);
        if (tid < 32) hist[tid] = 0u;
        __syncthreads();
        for (int i = bx * NTHREADS + tid; i < MOE_CAP; i += G * NTHREADS) tokk[i] = -1;
        if (bx == 0) ((GAS unsigned*)(XN2 + (size_t)MX * D))[tid] = 0u;
        for (int m = gw; m < MX; m += NGW) moe_row(out + (size_t)m * D, args.in[25], XN2 + (size_t)m * D, args.in[26], args.in[27], args.in[28], args.in[29], te, tg, m, hist, lane);
        LAS float* scr = (LAS float*)(lds + wave * 16384);
        for (int it = gw; it < 24576; it += NGW) {
            if (it < 16384) { const int up = it >> 13, r = it & 8191, e = r >> 8, q = r & 255, kb = q >> 4, nb = q & 15, n0 = 32 * nb;
                transpose_item(args.in[30 + up] + (size_t)e * 524288, 512, WGU, 1024, e * 1024 + (n0 >> 7) * 256 + up * 128 + (n0 & 127), 64 * kb, n0, scr, lane); }
            else { const int r = it - 16384, e = r >> 8, q = r & 255, kb = q >> 5, nb = q & 31;
                transpose_item(args.in[32] + (size_t)e * 524288, 1024, WDN, 512, e * 1024 + 32 * nb, 64 * kb, 32 * nb, scr, lane); }
        }
        __syncthreads();
        if (tid < 32) __hip_atomic_fetch_add(ctl + RW_CNT + tid, hist[tid], RLX_AGENT);
    }
    xcd_barrier(bar);
    {
        LAS unsigned* st = (LAS unsigned*)(lds + 131072);
        if (tid == 0) { unsigned run = 0u;
            for (int e = 0; e < NEXP; ++e) { const unsigned cn = __hip_atomic_load(ctl + RW_CNT + e, RLX_AGENT); st[e] = run; const unsigned nt_ = (cn + 255u) >> 8;
                if (bx == 0) for (unsigned j = 0; j < nt_; ++j) __hip_atomic_store(ctl + RW_TE + (run >> 8) + j, (unsigned)e, RLX_AGENT);
                run += nt_ << 8; }
            if (bx == 0) __hip_atomic_store(ctl + RW_NT, run >> 8, RLX_AGENT); }
        __syncthreads();
        if (lane < 16) { const int m = gw + NGW * (lane >> 1), a = lane & 1;
            if (m < MX) { const int e = te[2 * m + a]; const unsigned pos = __hip_atomic_fetch_add(ctl + RW_CUR + e, 1u, RLX_AGENT); const unsigned slot = st[e] + pos;
                tokk[slot] = 2 * m + a; rgate[slot] = tg[2 * m + a]; } }
    }
    xcd_barrier(bar);
    const int ntile = (int)__hip_atomic_load(ctl + RW_NT, RLX_AGENT);
    {
        pg8::Gemm g{XN2, WGU, 0, 0, D}; pg8::MoeOrder S{tokk, (const unsigned*)(ws + WS_CTL) + RW_TE, ntile, G, vcu, true, 2048u};
        pg8::EpiSwiGLU E{HID};
        pg8::gemm_phase_g<pg8::EpiSwiGLU, pg8::MoeOrder>(lds, g, S, E);
    }
    xcd_barrier(bar);
    {
        pg8::Gemm g{HID, WDN, 0, 0, EFF}; pg8::MoeOrder S{tokk, (const unsigned*)(ws + WS_CTL) + RW_TE, ntile, G, vcu, false, 1024u};
        pg8::EpiMoeDown E{tokk, rgate, out, Y1};
        pg8::gemm_phase_g<pg8::EpiMoeDown, pg8::MoeOrder>(lds, g, S, E);
    }
    xcd_barrier(bar);
    {
        for (int m = gw; m < MX; m += NGW) {
            GAS f32x4* o = (GAS f32x4*)(out + (size_t)m * D) + lane; const GAS v2u* y = (const GAS v2u*)(Y1 + (size_t)m * D) + lane;
#pragma unroll
            for (int j = 0; j < 4; ++j) { const v2u w = y[64 * j]; f32x4 v = o[64 * j]; v.x += bflo(w.x); v.y += bfhi(w.x); v.z += bflo(w.y); v.w += bfhi(w.y); o[64 * j] = v; }
        }
    }
}

extern "C" void kernel_launch(void* const* d_in, const int* in_sizes, int n_in, void* d_out, int out_size, void* d_ws, size_t ws_size, hipStream_t stream) {
    static int grid = 0;
    if (grid == 0) {
        if (n_in != 33 || out_size != MX * D || ws_size < WS_END) { fprintf(stderr, "kernel_launch: unexpected shapes n_in %d out %d ws %zu\n", n_in, out_size, ws_size); grid = -1; return; }
        int dev = 0, cus = 0;
        if (hipGetDevice(&dev) != hipSuccess || hipDeviceGetAttribute(&cus, hipDeviceAttributeMultiprocessorCount, dev) != hipSuccess) { grid = -1; return; }
        if (hipFuncSetAttribute((const void*)fwd_kernel, hipFuncAttributeMaxDynamicSharedMemorySize, LDS_BYTES) != hipSuccess) { fprintf(stderr, "kernel_launch: hipFuncSetAttribute failed\n"); grid = -1; return; }
        int per_cu = 0;
        if (hipOccupancyMaxActiveBlocksPerMultiprocessor(&per_cu, (const void*)fwd_kernel, NTHREADS, LDS_BYTES) != hipSuccess || per_cu < 1) fprintf(stderr, "kernel_launch: occupancy query says %d\n", per_cu);
        (void)hipGetLastError();
        grid = cus;
    }
    if (grid < 0) return;
    (void)hipMemsetAsync((char*)d_ws + WS_CTL, 0, CTL_ZERO_BYTES, stream);
    Args a{};
    for (int i = 0; i < 33; ++i) a.in[i] = (const float*)d_in[i];
    a.out = (float*)d_out; a.ws = (unsigned char*)d_ws;
    hipLaunchKernelGGL(fwd_kernel, dim3(grid), dim3(NTHREADS), LDS_BYTES, stream, a);
}
```

```cpp
#include <hip/hip_runtime.h>
#include <cstdio>
#include <cstdint>
#include <cmath>
#ifndef REP_PHASE
#define REP_PHASE -1
#endif
constexpr int D = 1024, NB = 8, SEQ = 2048, NMETA = 16, MX = NB * SEQ  , MROWS = MX + NMETA  , MPAD = MX + 256;
constexpr int RW_COLS = 3328, DF_COLS = 3072, GT_COLS = 2048, IN_COLS = RW_COLS + DF_COLS + GT_COLS;
constexpr int NEXP = 32, EFF = 512;
constexpr float NORM_EPS = 1e-6f;
constexpr size_t MiB = 1u << 20;
constexpr size_t WS_CTL = 0, CTL_ZERO_BYTES = 1 * MiB;
constexpr size_t WS_SMALL = 1 * MiB;
constexpr size_t WS_WBR = 2 * MiB, WS_WBD = 4 * MiB, WS_WOUT = 6 * MiB;
constexpr size_t WS_WIN = 8 * MiB;
constexpr size_t WS_PG = 25 * MiB;
constexpr size_t WS_PR = 89 * MiB;
constexpr size_t WS_PD = 194 * MiB;
constexpr size_t WS_END = 291 * MiB;
static_assert(WS_WIN + (size_t)IN_COLS * D * 2 <= WS_PG && WS_PG + (size_t)MX * GT_COLS * 2 <= WS_PR && WS_PR + (size_t)MROWS * RW_COLS * 2 <= WS_PD && WS_PD + (size_t)MROWS * DF_COLS * 2 <= WS_END, "ws map");
constexpr size_t WS_MRG = 89 * MiB;
constexpr size_t WS_XN2 = 121 * MiB;
constexpr size_t WS_WGU = 154 * MiB;
constexpr size_t WS_WDN = 218 * MiB;
constexpr size_t WS_HID = 250 * MiB;
constexpr size_t WS_Y1 = 25 * MiB;
constexpr int CW_TMO = 0, CW_CODE = 1, CW_BAR = 4096, CW_QUEUE = 16384, CW_ROUTE = 32768;
namespace pg8 {
#define PG8_LAS __attribute__((address_space(3)))
typedef unsigned short bf16_t;
typedef short bf16x8 __attribute__((ext_vector_type(8)));
typedef float f32x4 __attribute__((ext_vector_type(4)));
typedef unsigned u32x4 __attribute__((ext_vector_type(4)));
constexpr int BM = 256, BK = 64, HALF = 128, HTB = HALF * BK * 2  , STAGE_BYTES = 8 * HTB, NXCD = 8, WGM = 4;

__host__ __device__ __forceinline__ int lds_byte(int r, int c) { const int st = (r >> 4) * 2 + (c >> 5), rr = r & 15, cc = c & 31, ob = rr * 64 + cc * 2; return st * 1024 + (ob ^ (((ob >> 9) & 1) << 5)); }
__host__ __device__ __forceinline__ void stage_rc(int b, int& R, int& C) { const int st = b / 1024, sb = b % 1024, swz = sb ^ (((sb >> 9) & 1) << 5); R = (st >> 1) * 16 + swz / 64; C = (st & 1) * 32 + (swz % 64) / 2; }
__host__ __device__ __forceinline__ int perm32(int rho) { const int n = rho >> 4, i = rho & 15; return 8 * (i >> 2) + 4 * n + (i & 3); }

struct Unit { int pm, pn; };
struct Gemm { const bf16_t* A; const bf16_t* Bt; int M, N, K; };

struct StaticOrder {
    int nM, nN, nwg, G, c;
    __host__ __device__ void init(int M, int N, int G_, int c_) { nM = M / BM; nN = N / BM; nwg = nM * nN; G = G_; c = c_; }
    __host__ __device__ bool next(int i, Unit& u) const {
        const long L = (long)i * G + c; if (L >= nwg) return false;
        int wgid = (int)L; { const int q = nwg / NXCD, r = nwg % NXCD, xcd = wgid % NXCD, off = wgid / NXCD; wgid = (xcd < r ? xcd * (q + 1) : r * (q + 1) + (xcd - r) * q) + off; }
        const int nig = WGM * nN, gid = wgid / nig, fm = gid * WGM, gsz = (nM - fm) < WGM ? (nM - fm) : WGM;
        u.pm = fm + ((wgid % nig) % gsz); u.pn = (wgid % nig) / gsz; return true;
    }
    __device__ __forceinline__ void a_ready(const Unit&) const {}
    __device__ __forceinline__ void done(const Unit&) const {}
};

__device__ __forceinline__ unsigned cvt_pk_bf16(float lo, float hi) { unsigned r; asm volatile("v_cvt_pk_bf16_f32 %0, %1, %2" : "=v"(r) : "v"(lo), "v"(hi)); return r; }
typedef float f32x2 __attribute__((ext_vector_type(2)));
template <class Epi, class Sched, bool ALIGN_EPI = false, bool SP2 = false>
__device__ __forceinline__ void gemm_phase(PG8_LAS unsigned char* lds, const Gemm g, const Sched& S, const Epi& E) {
    int tid_ = threadIdx.x; asm volatile("" : "+v"(tid_)); const int tid = tid_, wid = __builtin_amdgcn_readfirstlane(tid >> 6), lane = tid & 63, wr = wid >> 2, wc = wid & 3, fr = lane & 15, fq = lane >> 4;
    const int K = g.K, nt = K / BK;
    unsigned voffA[2], voffB[2];
#pragma unroll
    for (int i = 0; i < 2; ++i) { int R, C; stage_rc(tid * 16 + i * 8192, R, C); const int Rb = Epi::PERM ? ((R & ~31) + perm32(R & 31)) : R;
        voffA[i] = (unsigned)(R * K + C) * 2u; voffB[i] = (unsigned)(Rb * K + C) * 2u; }
    const size_t kstep = (size_t)(BK * 2);
    const size_t hstep = (size_t)HALF * K * 2;
    const size_t tstep = 2 * hstep;
    const unsigned ldsw = (unsigned)wid * 1024u;
    const int aoff = lds_byte(wr * 64 + fr, fq * 8), boff = lds_byte(wc * 32 + fr, fq * 8);
#define PG8_SA(b, h) (((b) * 2 + (h)) * HTB)
#define PG8_SB(b, h) ((4 + (b) * 2 + (h)) * HTB)
#define PG8_STAGE(bufoff, gbase, voff) do { _Pragma("unroll") for (int _i = 0; _i < 2; ++_i) \
        __builtin_amdgcn_global_load_lds((const unsigned*)((const char*)(gbase) + (voff)[_i]), (PG8_LAS unsigned*)(lds + (bufoff) + ldsw + _i * 8192), 16, 0, 0); } while (0)
#define PG8_LDA(dst, b, h) do { _Pragma("unroll") for (int m = 0; m < 4; ++m) _Pragma("unroll") for (int k = 0; k < 2; ++k) dst[m][k] = *(const PG8_LAS bf16x8*)(lds + PG8_SA(b, h) + aoff + m * 2048 + k * 1024); } while (0)
#define PG8_LDB(dst, b, h) do { _Pragma("unroll") for (int n = 0; n < 2; ++n) _Pragma("unroll") for (int k = 0; k < 2; ++k) dst[n][k] = *(const PG8_LAS bf16x8*)(lds + PG8_SB(b, h) + boff + n * 2048 + k * 1024); } while (0)
#define PG8_MMA(ai, bj, At, Bt) do { __builtin_amdgcn_s_setprio(1); _Pragma("unroll") for (int m = 0; m < 4; ++m) _Pragma("unroll") for (int n = 0; n < 2; ++n) _Pragma("unroll") for (int k = 0; k < 2; ++k) \
        acc[ai][bj][m][n] = __builtin_amdgcn_mfma_f32_16x16x32_bf16(Bt[n][k], At[m][k], acc[ai][bj][m][n], 0, 0, 0); __builtin_amdgcn_s_setprio(0); } while (0)
#define PG8_WAIT_V(n) asm volatile("s_waitcnt vmcnt(" #n ")" ::: "memory")
#define PG8_WAIT_L(n) asm volatile("s_waitcnt lgkmcnt(" #n ")" ::: "memory")
#define PG8_BAR __builtin_amdgcn_s_barrier()
#define PG8_SCHED __builtin_amdgcn_sched_barrier(0)
    Unit cur, nxt; int ui = 0;
    if (!S.next(0, cur)) return;
    f32x4 acc[2][2][4][2];
#pragma unroll
    for (int a = 0; a < 2; ++a)
#pragma unroll
        for (int b = 0; b < 2; ++b)
#pragma unroll
            for (int m = 0; m < 4; ++m)
#pragma unroll
                for (int n = 0; n < 2; ++n) acc[a][b][m][n] = (f32x4){0.f, 0.f, 0.f, 0.f};
    bf16x8 At[4][2], B0[2][2], B1[2][2];
    const char* cA = (const char*)g.A + (size_t)cur.pm * tstep; const char* cB = (const char*)g.Bt + (size_t)cur.pn * tstep;
    S.a_ready(cur);
    if constexpr (SP2) {
        PG8_STAGE(PG8_SB(0, 0), cB, voffB); PG8_STAGE(PG8_SB(0, 1), cB + hstep, voffB); PG8_STAGE(PG8_SA(0, 0), cA, voffA); PG8_STAGE(PG8_SA(0, 1), cA + hstep, voffA);
        if (wr == 1) PG8_BAR;
        PG8_WAIT_V(2); PG8_BAR;
        PG8_STAGE(PG8_SB(1, 0), cB + kstep, voffB); PG8_STAGE(PG8_SA(1, 0), cA + kstep, voffA); PG8_STAGE(PG8_SB(1, 1), cB + hstep + kstep, voffB);
        PG8_WAIT_V(6); PG8_BAR;
    } else {
        PG8_STAGE(PG8_SB(0, 0), cB, voffB); PG8_STAGE(PG8_SA(0, 0), cA, voffA); PG8_STAGE(PG8_SB(0, 1), cB + hstep, voffB); PG8_STAGE(PG8_SA(0, 1), cA + hstep, voffA);
        if (wr == 1) PG8_BAR;
        PG8_WAIT_V(4); PG8_BAR;
        PG8_STAGE(PG8_SB(1, 0), cB + kstep, voffB); PG8_STAGE(PG8_SA(1, 0), cA + kstep, voffA); PG8_STAGE(PG8_SB(1, 1), cB + hstep + kstep, voffB);
        PG8_WAIT_V(6); PG8_BAR;
    }
    for (;;) {
        const bool has_next = S.next(ui + 1, nxt);
        const char* nA = has_next ? (const char*)g.A + (size_t)nxt.pm * tstep : cA; const char* nB = has_next ? (const char*)g.Bt + (size_t)nxt.pn * tstep : cB;
        for (int t = 0; t < nt; t += 2) {
            const bool last = (t == nt - 2);
            const char* a1 = cA + (size_t)(t + 1) * kstep;
            const char* a2 = last ? nA : cA + (size_t)(t + 2) * kstep; const char* b2 = last ? nB : cB + (size_t)(t + 2) * kstep;
            const char* a3 = a2 + kstep; const char* b3 = b2 + kstep;
            if (last && has_next) S.a_ready(nxt);
            if constexpr (SP2) {
            PG8_LDB(B0, 0, 0); PG8_LDB(B1, 0, 1); PG8_SCHED; PG8_LDA(At, 0, 0); PG8_STAGE(PG8_SA(1, 1), a1 + hstep, voffA);
            PG8_WAIT_V(8); PG8_WAIT_L(0); PG8_BAR; PG8_MMA(0, 0, At, B0); PG8_MMA(0, 1, At, B1); PG8_BAR; PG8_SCHED;
            PG8_LDA(At, 0, 1); PG8_STAGE(PG8_SB(0, 0), b2, voffB); PG8_STAGE(PG8_SB(0, 1), b2 + hstep, voffB); PG8_STAGE(PG8_SA(0, 0), a2, voffA);
            PG8_WAIT_V(8); PG8_WAIT_L(0); PG8_BAR; PG8_MMA(1, 0, At, B0); PG8_MMA(1, 1, At, B1); PG8_BAR; PG8_SCHED;
            PG8_LDB(B0, 1, 0); PG8_LDB(B1, 1, 1); PG8_SCHED; PG8_LDA(At, 1, 0); PG8_STAGE(PG8_SA(0, 1), a2 + hstep, voffA);
            PG8_WAIT_V(8); PG8_WAIT_L(0); PG8_BAR; PG8_MMA(0, 0, At, B0); PG8_MMA(0, 1, At, B1); PG8_BAR; PG8_SCHED;
            PG8_LDA(At, 1, 1); PG8_STAGE(PG8_SB(1, 0), b3, voffB); PG8_STAGE(PG8_SB(1, 1), b3 + hstep, voffB); PG8_STAGE(PG8_SA(1, 0), a3, voffA);
            PG8_WAIT_V(8); PG8_WAIT_L(0); PG8_BAR; PG8_MMA(1, 0, At, B0); PG8_MMA(1, 1, At, B1); PG8_BAR; PG8_SCHED;
            } else {
            PG8_LDB(B0, 0, 0); PG8_SCHED; PG8_LDA(At, 0, 0); PG8_STAGE(PG8_SA(1, 1), a1 + hstep, voffA);
            PG8_WAIT_L(8); PG8_BAR; PG8_WAIT_L(0); PG8_MMA(0, 0, At, B0); PG8_BAR; PG8_SCHED;
            PG8_LDB(B1, 0, 1); PG8_STAGE(PG8_SB(0, 0), b2, voffB);
            PG8_BAR; PG8_WAIT_L(0); PG8_MMA(0, 1, At, B1); PG8_BAR;
            PG8_LDA(At, 0, 1); PG8_STAGE(PG8_SA(0, 0), a2, voffA);
            PG8_BAR; PG8_WAIT_L(0); PG8_MMA(1, 0, At, B0); PG8_BAR; PG8_SCHED;
            PG8_STAGE(PG8_SB(0, 1), b2 + hstep, voffB);
            PG8_WAIT_V(6); PG8_BAR; PG8_MMA(1, 1, At, B1); PG8_BAR;
            PG8_LDB(B0, 1, 0); PG8_SCHED; PG8_LDA(At, 1, 0); PG8_STAGE(PG8_SA(0, 1), a2 + hstep, voffA);
            PG8_WAIT_L(8); PG8_BAR; PG8_WAIT_L(0); PG8_MMA(0, 0, At, B0); PG8_BAR; PG8_SCHED;
            PG8_LDB(B1, 1, 1); PG8_STAGE(PG8_SB(1, 0), b3, voffB);
            PG8_BAR; PG8_WAIT_L(0); PG8_MMA(0, 1, At, B1); PG8_BAR;
            PG8_LDA(At, 1, 1); PG8_STAGE(PG8_SA(1, 0), a3, voffA);
            PG8_BAR; PG8_WAIT_L(0); PG8_MMA(1, 0, At, B0); PG8_BAR; PG8_SCHED;
            PG8_STAGE(PG8_SB(1, 1), b3 + hstep, voffB);
            PG8_WAIT_V(6); PG8_BAR; PG8_MMA(1, 1, At, B1); PG8_BAR;
            }
        }
        if constexpr (ALIGN_EPI) { if (wr == 0) PG8_BAR; }
        if constexpr (!Epi::AFTER_DRAIN) { E(acc, cur, wr, wc, fr, fq); if (REP_PHASE == 40) E(acc, cur, wr, wc, fr, fq); S.done(cur); }
        if (!has_next) break;
#pragma unroll
        for (int a = 0; a < 2; ++a)
#pragma unroll
            for (int b = 0; b < 2; ++b)
#pragma unroll
                for (int m = 0; m < 4; ++m)
#pragma unroll
                    for (int n = 0; n < 2; ++n) acc[a][b][m][n] = (f32x4){0.f, 0.f, 0.f, 0.f};
        cur = nxt; cA = nA; cB = nB; ++ui;
        if constexpr (ALIGN_EPI) { if (wr == 1) PG8_BAR; }
    }
    PG8_WAIT_V(0);
    if constexpr (!ALIGN_EPI) { if (wr == 0) PG8_BAR; }
    PG8_BAR;
    if constexpr (Epi::AFTER_DRAIN) { E.fused(acc, cur, wr, wc, fr, fq, lds, wid, lane); S.done(cur); }
#undef PG8_SA
#undef PG8_SB
#undef PG8_STAGE
#undef PG8_LDA
#undef PG8_LDB
#undef PG8_MMA
#undef PG8_WAIT_V
#undef PG8_WAIT_L
#undef PG8_BAR
#undef PG8_SCHED
}
}
#define GAS __attribute__((address_space(1)))
#define LAS __attribute__((address_space(3)))
typedef unsigned short bf16;
typedef unsigned v4u __attribute__((ext_vector_type(4)));
typedef unsigned v2u __attribute__((ext_vector_type(2)));
typedef float f32x4 __attribute__((ext_vector_type(4)));
typedef float f32x2 __attribute__((ext_vector_type(2)));
typedef short bf16x8 __attribute__((ext_vector_type(8)));
typedef short s16x4 __attribute__((ext_vector_type(4)));
typedef float f32x16 __attribute__((ext_vector_type(16)));
typedef GAS unsigned gu32;
#define RLX_AGENT __ATOMIC_RELAXED, __HIP_MEMORY_SCOPE_AGENT
#define LDS_WAIT() asm volatile("s_waitcnt lgkmcnt(0)" ::: "memory")
#define VM_WAIT() asm volatile("s_waitcnt vmcnt(0)" ::: "memory")
constexpr int NWAVES = 8, NTHREADS = 512;
constexpr int LDS_BYTES = 160 * 1024;
constexpr int LDSCTL_OFF = LDS_BYTES - 512, MISC_OFF = LDSCTL_OFF + 256;
typedef __bf16 hwbf16x2_t __attribute__((ext_vector_type(2)));
__device__ __forceinline__ unsigned pk2(float lo, float hi) { f32x2 v = {lo, hi}; return __builtin_bit_cast(unsigned, __builtin_convertvector(v, hwbf16x2_t)); }
__device__ __forceinline__ unsigned f2bf(float f) { return (unsigned)__builtin_bit_cast(unsigned short, (__bf16)f); }
__device__ __forceinline__ float bf2f(unsigned short b) { return __builtin_bit_cast(float, (unsigned)b << 16); }
__device__ __forceinline__ float bflo(unsigned w) { return __builtin_bit_cast(float, w << 16); }
__device__ __forceinline__ float bfhi(unsigned w) { return __builtin_bit_cast(float, w & 0xffff0000u); }
__device__ __forceinline__ float sigmoidf_(float x) { return 1.0f / (1.0f + __expf(-x)); }
__device__ __forceinline__ float wave_sum(float v) {
#pragma unroll
    for (int o = 1; o < 64; o <<= 1) v += __shfl_xor(v, o);
    return v;
}
#define XB_TMO      128
#define XB_XCNT(j)  (256  + 64 * (j))
#define XB_XSUB(j)  (1280 + 64 * (j))
#define XB_XGEN(j)  (2304 + 64 * (j))
#define XB_TOP      3328
#define XB_TOPGEN   3392
#define XCD_BAR_WORDS 3456
#define XB_SPIN_CAP (1u << 18)

__device__ __forceinline__ unsigned xb_ld(unsigned* p)              { return __hip_atomic_load(p, __ATOMIC_RELAXED, __HIP_MEMORY_SCOPE_AGENT); }
__device__ __forceinline__ unsigned xb_add(unsigned* p, unsigned v) { return __hip_atomic_fetch_add(p, v, __ATOMIC_RELAXED, __HIP_MEMORY_SCOPE_AGENT); }
__device__ __forceinline__ unsigned xb_xcc_id() { return (unsigned)__builtin_amdgcn_s_getreg((3 << 11) | 20) & 0xFu; }
#define XB_SPIN(cond, bar) do { unsigned _sp = 0; while (cond) { __builtin_amdgcn_s_sleep(1); \
    if ((++_sp & 255u) == 0u) { if (xb_ld(&(bar)[XB_TMO])) break; if (_sp > XB_SPIN_CAP) { atomicAdd(&(bar)[XB_TMO], 1u); break; } } } } while (0)

struct XcdBarrier {
    unsigned* bar; unsigned x;
    volatile LAS unsigned* st;
};

__device__ __forceinline__ XcdBarrier xcd_barrier_post(unsigned* bar, volatile LAS unsigned* st) {
    XcdBarrier b; b.bar = bar; b.x = xb_xcc_id(); b.st = st;
    if (threadIdx.x == 0) (void)xb_add(&bar[XB_XCNT(b.x)], 1u);
    return b;
}
__device__ __forceinline__ void xcd_barrier_complete(unsigned* bar, unsigned x, unsigned& nloc, unsigned& nx) {
    const unsigned G = gridDim.x * gridDim.y * gridDim.z;
    unsigned sum, cnt, mine, sp = 0u;
    for (;;) {
        sum = 0u; cnt = 0u; mine = 0u;
#pragma unroll
        for (unsigned j = 0; j < 16; ++j) { const unsigned c = xb_ld(&bar[XB_XCNT(j)]); sum += c; cnt += (c > 0u) ? 1u : 0u; mine = (j == x) ? c : mine; }
        if (sum == G) break;
        __builtin_amdgcn_s_sleep(1);
        if ((++sp & 255u) == 0u) { if (xb_ld(&bar[XB_TMO])) break; if (sp > XB_SPIN_CAP) { atomicAdd(&bar[XB_TMO], 1u); break; } }
    }
    nloc = mine > 0u ? mine : 1u; nx = cnt > 0u ? cnt : 1u;
}

__device__ __forceinline__ void xcd_barrier(const XcdBarrier& b) {
    asm volatile("s_waitcnt vmcnt(0)" ::: "memory");
    __syncthreads();
    if (threadIdx.x == 0) {
        unsigned* bar = b.bar;
        __builtin_amdgcn_s_waitcnt(0);
        unsigned nloc = b.st[0], nx = b.st[1];
        if (nloc == 0u) { xcd_barrier_complete(bar, b.x, nloc, nx); b.st[0] = nloc; b.st[1] = nx; }
        const unsigned old = xb_add(&bar[XB_XSUB(b.x)], 1u);
        const unsigned gen = old / nloc;
        if (old + 1u == (gen + 1u) * nloc) {
            __builtin_amdgcn_fence(__ATOMIC_RELEASE, "agent");
            asm volatile("s_waitcnt vmcnt(0)" ::: "memory");
            const unsigned og = xb_add(&bar[XB_TOP], 1u);
            const unsigned tg = og / nx;
            if (og + 1u == (tg + 1u) * nx) xb_add(&bar[XB_TOPGEN], 1u);
            else XB_SPIN(xb_ld(&bar[XB_TOPGEN]) == tg, bar);
            __builtin_amdgcn_fence(__ATOMIC_ACQUIRE, "agent");
            xb_add(&bar[XB_XGEN(b.x)], 1u);
            asm volatile("s_waitcnt vmcnt(0)" ::: "memory");
        } else {
            XB_SPIN(xb_ld(&bar[XB_XGEN(b.x)]) == gen, bar);
            __builtin_amdgcn_fence(__ATOMIC_ACQUIRE, "agent");
            asm volatile("s_waitcnt vmcnt(0)" ::: "memory");
        }
    }
    __syncthreads();
}
namespace pg8 {
struct EpiInProj {
    static constexpr bool PERM = true, AFTER_DRAIN = false;
    bf16_t* PR; bf16_t* PD; bf16_t* PG; const float* qnw; const float* knw; const float* cs;
    __device__ __forceinline__ void operator()(const f32x4 (&acc)[2][2][4][2], const Unit& u, int wr, int wc, int fr, int fq) const {
        const int pn = u.pn; const int row0 = u.pm * BM + wr * 64 + fr;
        if (pn >= 13 && pn < 21) {
            const bool isq = pn < 17; const float* nw = isq ? qnw : knw; const float qs = isq ? 0.125f * 1.4426950408889634f : 1.0f;
            f32x4 wgt[2][2];
#pragma unroll
            for (int bj = 0; bj < 2; ++bj)
#pragma unroll
                for (int n = 0; n < 2; ++n) wgt[bj][n] = *(const f32x4*)(nw + 32 * bj + 8 * fq + 4 * n) * qs;
            const unsigned col = (unsigned)((pn - 13) * 256 + 64 * wc + 8 * fq);
#pragma unroll
            for (int ai = 0; ai < 2; ++ai)
#pragma unroll
                for (int m = 0; m < 4; ++m) { const int row = row0 + ai * HALF + m * 16;
                    const int pos = row < 16384 ? 16 + (row & 2047) : (row - 16384 < 16 ? row - 16384 : 0);
                    const f32x4 c0 = *(const f32x4*)(cs + pos * 16), c1 = *(const f32x4*)(cs + pos * 16 + 4), s0 = *(const f32x4*)(cs + pos * 16 + 8), s1 = *(const f32x4*)(cs + pos * 16 + 12);
                    f32x4 v[2][2]; float ss = 0.f;
#pragma unroll
                    for (int bj = 0; bj < 2; ++bj)
#pragma unroll
                        for (int n = 0; n < 2; ++n) { v[bj][n] = acc[ai][bj][m][n]; ss += (v[bj][n][0] * v[bj][n][0] + v[bj][n][1] * v[bj][n][1]) + (v[bj][n][2] * v[bj][n][2] + v[bj][n][3] * v[bj][n][3]); }
                    ss += __shfl_xor(ss, 16); ss += __shfl_xor(ss, 32);
                    const float rstd = 1.0f / sqrtf(ss * (1.0f / 64.0f) + 1e-6f);
#pragma unroll
                    for (int bj = 0; bj < 2; ++bj)
#pragma unroll
                        for (int n = 0; n < 2; ++n) v[bj][n] = v[bj][n] * rstd * wgt[bj][n];
                    f32x4 o0, o1;
#pragma unroll
                    for (int e = 0; e < 4; ++e) { o0[e] = __shfl_xor(v[0][0][e], 16); o1[e] = __shfl_xor(v[0][1][e], 16); }
                    const float sgn = (fq == 0) ? -1.0f : 1.0f;
                    if (fq < 2) { v[0][0] = v[0][0] * c0 + o0 * s0 * sgn; v[0][1] = v[0][1] * c1 + o1 * s1 * sgn; }
                    if (row < 16400) {
#pragma unroll
                        for (int bj = 0; bj < 2; ++bj) { u32x4 w; w.x = cvt_pk_bf16(v[bj][0][0], v[bj][0][1]); w.y = cvt_pk_bf16(v[bj][0][2], v[bj][0][3]); w.z = cvt_pk_bf16(v[bj][1][0], v[bj][1][1]); w.w = cvt_pk_bf16(v[bj][1][2], v[bj][1][3]);
                            *(u32x4*)(PD + (unsigned)row * 3072u + col + 32 * bj) = w; } } }
            return;
        }
        const bool t0 = pn < 13, t1 = pn < 25, sg = !t1;
        const long long d1 = (const char*)PD - (const char*)PG, d0 = (const char*)PR - (const char*)PD;
        bf16_t* base = (bf16_t*)((char*)PG + (t1 ? d1 : 0ll) + (t0 ? d0 : 0ll)); const unsigned ldc = t0 ? 3328u : (t1 ? 3072u : 2048u); const int colt = (t0 ? pn : (t1 ? pn - 13 : pn - 25)) * 256;
        const int rowlim = sg ? 16384 : 16400;
        const unsigned off0 = (unsigned)row0 * ldc + (unsigned)(colt + wc * 32 + 8 * fq);
#pragma unroll
        for (int ai = 0; ai < 2; ++ai)
#pragma unroll
            for (int m = 0; m < 4; ++m) { const int row = row0 + ai * HALF + m * 16; const unsigned off = off0 + (unsigned)(ai * HALF + m * 16) * ldc;
                if (row < rowlim) {
#pragma unroll
                for (int bj = 0; bj < 2; ++bj) { f32x4 v0 = acc[ai][bj][m][0], v1 = acc[ai][bj][m][1];
                    if (sg) {
#pragma unroll
                        for (int e = 0; e < 4; ++e) { v0[e] = __builtin_amdgcn_rcpf(1.0f + __expf(-v0[e])); v1[e] = __builtin_amdgcn_rcpf(1.0f + __expf(-v1[e])); } }
                    u32x4 w; w.x = cvt_pk_bf16(v0[0], v0[1]); w.y = cvt_pk_bf16(v0[2], v0[3]); w.z = cvt_pk_bf16(v1[0], v1[1]); w.w = cvt_pk_bf16(v1[2], v1[3]);
                    *(u32x4*)(base + off + bj * HALF) = w; } } }
    }
};
struct InProjOrder {
    StaticOrder so; int G, c;
    __device__ void init(int G_, int c_) { so.init(16384, 8448, G_, c_); G = G_; c = c_; }
    __device__ bool next(int i, Unit& u) const {
        if (so.next(i, u)) return true;
        const long L = (long)i * G + c - so.nwg; if (L < 0 || L >= 21) return false;
        u.pm = 64; u.pn = (L < 13) ? (int)L : (int)L + 4; return true;
    }
    __device__ __forceinline__ void a_ready(const Unit&) const {}
    __device__ __forceinline__ void done(const Unit&) const {}
};
}
namespace pg8 {
struct EpiGate {
    static constexpr bool PERM = true, AFTER_DRAIN = false;
    const bf16_t* PG; int goff; const bf16_t* T1; bf16_t* O;
    __device__ __forceinline__ void operator()(const f32x4 (&acc)[2][2][4][2], const Unit& u, int wr, int wc, int fr, int fq) const {
        const int row0 = u.pm * BM + wr * 64 + fr, col0 = u.pn * BM + wc * 32 + 8 * fq;
#pragma unroll
        for (int ai = 0; ai < 2; ++ai) {
            u32x4 gw[4][2], tw[4][2];
#pragma unroll
            for (int m = 0; m < 4; ++m)
#pragma unroll
                for (int bj = 0; bj < 2; ++bj) { const size_t row = row0 + ai * HALF + m * 16; const int col = col0 + bj * HALF;
                    gw[m][bj] = *(const u32x4*)(PG + row * 2048 + goff + col);
                    if (T1) tw[m][bj] = *(const u32x4*)(T1 + row * 1024 + col); else tw[m][bj] = (u32x4){0u, 0u, 0u, 0u}; }
#pragma unroll
            for (int m = 0; m < 4; ++m)
#pragma unroll
                for (int bj = 0; bj < 2; ++bj) { const size_t row = row0 + ai * HALF + m * 16; const int col = col0 + bj * HALF;
                    const u32x4 g = gw[m][bj], t = tw[m][bj]; f32x4 v0 = acc[ai][bj][m][0], v1 = acc[ai][bj][m][1];
                    v0[0] = v0[0] * __builtin_bit_cast(float, g.x << 16) + __builtin_bit_cast(float, t.x << 16); v0[1] = v0[1] * __builtin_bit_cast(float, g.x & 0xffff0000u) + __builtin_bit_cast(float, t.x & 0xffff0000u);
                    v0[2] = v0[2] * __builtin_bit_cast(float, g.y << 16) + __builtin_bit_cast(float, t.y << 16); v0[3] = v0[3] * __builtin_bit_cast(float, g.y & 0xffff0000u) + __builtin_bit_cast(float, t.y & 0xffff0000u);
                    v1[0] = v1[0] * __builtin_bit_cast(float, g.z << 16) + __builtin_bit_cast(float, t.z << 16); v1[1] = v1[1] * __builtin_bit_cast(float, g.z & 0xffff0000u) + __builtin_bit_cast(float, t.z & 0xffff0000u);
                    v1[2] = v1[2] * __builtin_bit_cast(float, g.w << 16) + __builtin_bit_cast(float, t.w << 16); v1[3] = v1[3] * __builtin_bit_cast(float, g.w & 0xffff0000u) + __builtin_bit_cast(float, t.w & 0xffff0000u);
                    u32x4 w; w.x = cvt_pk_bf16(v0[0], v0[1]); w.y = cvt_pk_bf16(v0[2], v0[3]); w.z = cvt_pk_bf16(v1[0], v1[1]); w.w = cvt_pk_bf16(v1[2], v1[3]);
                    *(u32x4*)(O + row * 1024 + col) = w; }
            asm volatile("" ::: "memory");
        }
    }
};
struct BranchOrder {
    StaticOrder so;
    __device__ bool next(int i, Unit& u) const { if (!so.next(i >> 1, u)) return false; if (i & 1) { u.pm += 64; u.pn += 4; } return true; }
    __device__ __forceinline__ void a_ready(const Unit&) const {}
    __device__ __forceinline__ void done(const Unit&) const {}
};
struct EpiBranch {
    static constexpr bool PERM = true, AFTER_DRAIN = false;
    const bf16_t* PG; bf16_t* T1; bf16_t* O;
    __device__ __forceinline__ void operator()(const f32x4 (&acc)[2][2][4][2], const Unit& u, int wr, int wc, int fr, int fq) const {
        const bool seg1 = u.pn >= 4;
        const int row0 = (u.pm & 63) * BM + wr * 64 + fr, col0 = (u.pn & 3) * BM + wc * 32 + 8 * fq; const int goff = seg1 ? 1024 : 0;
        bf16_t* dst = seg1 ? O : T1;
#pragma unroll
        for (int ai = 0; ai < 2; ++ai) {
            u32x4 gw[4][2], tw[4][2];
#pragma unroll
            for (int m = 0; m < 4; ++m)
#pragma unroll
                for (int bj = 0; bj < 2; ++bj) { const size_t row = row0 + ai * HALF + m * 16; const int col = col0 + bj * HALF;
                    gw[m][bj] = *(const u32x4*)(PG + row * 2048 + goff + col);
                    tw[m][bj] = *(const u32x4*)(T1 + row * 1024 + col); }
#pragma unroll
            for (int m = 0; m < 4; ++m)
#pragma unroll
                for (int bj = 0; bj < 2; ++bj) { const size_t row = row0 + ai * HALF + m * 16; const int col = col0 + bj * HALF;
                    const u32x4 g = gw[m][bj]; u32x4 t = tw[m][bj]; if (!seg1) t = (u32x4){0u, 0u, 0u, 0u};
                    f32x4 v0 = acc[ai][bj][m][0], v1 = acc[ai][bj][m][1];
                    v0[0] = v0[0] * __builtin_bit_cast(float, g.x << 16) + __builtin_bit_cast(float, t.x << 16); v0[1] = v0[1] * __builtin_bit_cast(float, g.x & 0xffff0000u) + __builtin_bit_cast(float, t.x & 0xffff0000u);
                    v0[2] = v0[2] * __builtin_bit_cast(float, g.y << 16) + __builtin_bit_cast(float, t.y << 16); v0[3] = v0[3] * __builtin_bit_cast(float, g.y & 0xffff0000u) + __builtin_bit_cast(float, t.y & 0xffff0000u);
                    v1[0] = v1[0] * __builtin_bit_cast(float, g.z << 16) + __builtin_bit_cast(float, t.z << 16); v1[1] = v1[1] * __builtin_bit_cast(float, g.z & 0xffff0000u) + __builtin_bit_cast(float, t.z & 0xffff0000u);
                    v1[2] = v1[2] * __builtin_bit_cast(float, g.w << 16) + __builtin_bit_cast(float, t.w << 16); v1[3] = v1[3] * __builtin_bit_cast(float, g.w & 0xffff0000u) + __builtin_bit_cast(float, t.w & 0xffff0000u);
                    u32x4 w; w.x = cvt_pk_bf16(v0[0], v0[1]); w.y = cvt_pk_bf16(v0[2], v0[3]); w.z = cvt_pk_bf16(v1[0], v1[1]); w.w = cvt_pk_bf16(v1[2], v1[3]);
                    *(u32x4*)(dst + row * 1024 + col) = w; }
            asm volatile("" ::: "memory");
        }
    }
};
struct EpiResF32 {
    static constexpr bool PERM = false, AFTER_DRAIN = false;
    const float* res; float* O;
    __device__ __forceinline__ void operator()(const f32x4 (&acc)[2][2][4][2], const Unit& u, int wr, int wc, int fr, int fq) const {
        const int row0 = u.pm * BM + wr * 64 + fr, col0 = u.pn * BM + wc * 32 + 4 * fq;
#pragma unroll
        for (int ai = 0; ai < 2; ++ai) {
            f32x4 r[4][2][2];
#pragma unroll
            for (int m = 0; m < 4; ++m)
#pragma unroll
                for (int bj = 0; bj < 2; ++bj)
#pragma unroll
                    for (int n = 0; n < 2; ++n) r[m][bj][n] = *(const f32x4*)(res + (size_t)(row0 + ai * HALF + m * 16) * 1024 + col0 + bj * HALF + n * 16);
#pragma unroll
            for (int m = 0; m < 4; ++m)
#pragma unroll
                for (int bj = 0; bj < 2; ++bj)
#pragma unroll
                    for (int n = 0; n < 2; ++n) *(f32x4*)(O + (size_t)(row0 + ai * HALF + m * 16) * 1024 + col0 + bj * HALF + n * 16) = r[m][bj][n] + acc[ai][bj][m][n];
            asm volatile("" ::: "memory");
        }
    }
};
}
namespace pg8 {
struct Seg2 { int nt1; size_t dA, dB; };
template <class Epi, class Sched, int NT1 = 0, size_t DA = 0, size_t DB = 0>
__device__ __forceinline__ void gemm_phase_g(PG8_LAS unsigned char* lds, const Gemm g, const Sched& S, const Epi& E) {
    constexpr bool SEG2 = NT1 > 0; constexpr Seg2 sg{NT1, DA, DB};
    int tid_ = threadIdx.x; asm volatile("" : "+v"(tid_)); const int tid = tid_, wid = __builtin_amdgcn_readfirstlane(tid >> 6), lane = tid & 63, wr = wid >> 2, wc = wid & 3, fr = lane & 15, fq = lane >> 4;
    const int K = g.K, nt = K / BK;
    int RA[2], CA2[2]; unsigned voffB[2];
#pragma unroll
    for (int i = 0; i < 2; ++i) { int R, C; stage_rc(tid * 16 + i * 8192, R, C); const int Rb = Epi::PERM ? ((R & ~31) + perm32(R & 31)) : R; RA[i] = R; CA2[i] = C * 2; voffB[i] = (unsigned)(Rb * K + C) * 2u; }
    const size_t kstep = (size_t)(BK * 2);
#define PG8_KA(tt) (SEG2 && (tt) >= sg.nt1 ? sg.dA + (size_t)((tt) - sg.nt1) * kstep : (size_t)(tt) * kstep)
#define PG8_KB(tt) (SEG2 && (tt) >= sg.nt1 ? sg.dB + (size_t)((tt) - sg.nt1) * kstep : (size_t)(tt) * kstep)
    const size_t hstep = (size_t)HALF * K * 2;
    const size_t tstep = 2 * hstep;
    const unsigned ldsw = (unsigned)wid * 1024u;
    const int aoff = lds_byte(wr * 64 + fr, fq * 8), boff = lds_byte(wc * 32 + fr, fq * 8);
#define PG8_SA(b, h) (((b) * 2 + (h)) * HTB)
#define PG8_SB(b, h) ((4 + (b) * 2 + (h)) * HTB)
#define PG8_STAGE(bufoff, gbase, voff) do { _Pragma("unroll") for (int _i = 0; _i < 2; ++_i) \
        __builtin_amdgcn_global_load_lds((const unsigned*)((const char*)(gbase) + (voff)[_i]), (PG8_LAS unsigned*)(lds + (bufoff) + ldsw + _i * 8192), 16, 0, 0); } while (0)
#define PG8_STAGEA(bufoff, O, h, kb) do { _Pragma("unroll") for (int _i = 0; _i < 2; ++_i) \
        __builtin_amdgcn_global_load_lds((const unsigned*)((const char*)g.A + (size_t)(O)[h][_i] + (kb)), (PG8_LAS unsigned*)(lds + (bufoff) + ldsw + _i * 8192), 16, 0, 0); } while (0)
#define PG8_LDA(dst, b, h) do { _Pragma("unroll") for (int m = 0; m < 4; ++m) _Pragma("unroll") for (int k = 0; k < 2; ++k) dst[m][k] = *(const PG8_LAS bf16x8*)(lds + PG8_SA(b, h) + aoff + m * 2048 + k * 1024); } while (0)
#define PG8_LDB(dst, b, h) do { _Pragma("unroll") for (int n = 0; n < 2; ++n) _Pragma("unroll") for (int k = 0; k < 2; ++k) dst[n][k] = *(const PG8_LAS bf16x8*)(lds + PG8_SB(b, h) + boff + n * 2048 + k * 1024); } while (0)
#define PG8_MMA(ai, bj, At, Bt) do { __builtin_amdgcn_s_setprio(1); _Pragma("unroll") for (int m = 0; m < 4; ++m) _Pragma("unroll") for (int n = 0; n < 2; ++n) _Pragma("unroll") for (int k = 0; k < 2; ++k) \
        acc[ai][bj][m][n] = __builtin_amdgcn_mfma_f32_16x16x32_bf16(Bt[n][k], At[m][k], acc[ai][bj][m][n], 0, 0, 0); __builtin_amdgcn_s_setprio(0); } while (0)
#define PG8_WAIT_V(n) asm volatile("s_waitcnt vmcnt(" #n ")" ::: "memory")
#define PG8_WAIT_L(n) asm volatile("s_waitcnt lgkmcnt(" #n ")" ::: "memory")
#define PG8_BAR __builtin_amdgcn_s_barrier()
#define PG8_SCHED __builtin_amdgcn_sched_barrier(0)
#define PG8_AOFF(O, u) do { _Pragma("unroll") for (int _h = 0; _h < 2; ++_h) _Pragma("unroll") for (int _i = 0; _i < 2; ++_i) (O)[_h][_i] = S.a_row_off((u), _h * HALF + RA[_i]) + (unsigned)CA2[_i]; } while (0)
    Unit cur, nxt; int ui = 0;
    if (!S.next(0, cur)) return;
    f32x4 acc[2][2][4][2];
#pragma unroll
    for (int a = 0; a < 2; ++a)
#pragma unroll
        for (int b = 0; b < 2; ++b)
#pragma unroll
            for (int m = 0; m < 4; ++m)
#pragma unroll
                for (int n = 0; n < 2; ++n) acc[a][b][m][n] = (f32x4){0.f, 0.f, 0.f, 0.f};
    bf16x8 At[4][2], B0[2][2], B1[2][2];
    unsigned cO[2][2], nO[2][2];
    PG8_AOFF(cO, cur);
    const char* cB = (const char*)g.Bt + (size_t)cur.pn * tstep;
    PG8_STAGE(PG8_SB(0, 0), cB, voffB); PG8_STAGE(PG8_SB(0, 1), cB + hstep, voffB); PG8_STAGEA(PG8_SA(0, 0), cO, 0, 0); PG8_STAGEA(PG8_SA(0, 1), cO, 1, 0);
    if (wr == 1) PG8_BAR;
    PG8_WAIT_V(2); PG8_BAR;
    PG8_STAGE(PG8_SB(1, 0), cB + kstep, voffB); PG8_STAGEA(PG8_SA(1, 0), cO, 0, kstep); PG8_STAGE(PG8_SB(1, 1), cB + hstep + kstep, voffB);
    PG8_WAIT_V(6); PG8_BAR;
    for (;;) {
        const bool has_next = S.next(ui + 1, nxt);
        if constexpr (Sched::GATHER) { if (has_next) { PG8_AOFF(nO, nxt); } else {
#pragma unroll
            for (int _h = 0; _h < 2; ++_h)
#pragma unroll
                for (int _i = 0; _i < 2; ++_i) nO[_h][_i] = cO[_h][_i]; } }
        const char* nB = has_next ? (const char*)g.Bt + (size_t)nxt.pn * tstep : cB;
        for (int t = 0; t < nt; t += 2) {
            const bool last = (t == nt - 2);
            if constexpr (SEG2) { if (t == sg.nt1) { PG8_SCHED; E.mid(acc, cur, wr, wc, fr, fq); PG8_SCHED; } }
            const size_t k1 = PG8_KA(t + 1), k2 = last ? 0 : PG8_KA(t + 2), k3 = last ? kstep : PG8_KA(t + 3);
            unsigned o2[2][2];
            if constexpr (Sched::GATHER) {
#pragma unroll
                for (int _h = 0; _h < 2; ++_h)
#pragma unroll
                    for (int _i = 0; _i < 2; ++_i) o2[_h][_i] = last ? nO[_h][_i] : cO[_h][_i];
            } else { const Unit uu = (last && has_next) ? nxt : cur; PG8_AOFF(o2, uu); }
            const char* b2 = last ? nB : cB + PG8_KB(t + 2); const char* b3 = last ? nB + kstep : cB + PG8_KB(t + 3);
            PG8_LDB(B0, 0, 0); PG8_LDB(B1, 0, 1); PG8_SCHED; PG8_LDA(At, 0, 0); PG8_STAGEA(PG8_SA(1, 1), cO, 1, k1);
            PG8_WAIT_V(8); PG8_WAIT_L(0); PG8_BAR; PG8_MMA(0, 0, At, B0); PG8_MMA(0, 1, At, B1); PG8_BAR; PG8_SCHED;
            PG8_LDA(At, 0, 1); PG8_STAGE(PG8_SB(0, 0), b2, voffB); PG8_STAGE(PG8_SB(0, 1), b2 + hstep, voffB); PG8_STAGEA(PG8_SA(0, 0), o2, 0, k2);
            PG8_WAIT_V(8); PG8_WAIT_L(0); PG8_BAR; PG8_MMA(1, 0, At, B0); PG8_MMA(1, 1, At, B1); PG8_BAR; PG8_SCHED;
            PG8_LDB(B0, 1, 0); PG8_LDB(B1, 1, 1); PG8_SCHED; PG8_LDA(At, 1, 0); PG8_STAGEA(PG8_SA(0, 1), o2, 1, k2);
            PG8_WAIT_V(8); PG8_WAIT_L(0); PG8_BAR; PG8_MMA(0, 0, At, B0); PG8_MMA(0, 1, At, B1); PG8_BAR; PG8_SCHED;
            PG8_LDA(At, 1, 1); PG8_STAGE(PG8_SB(1, 0), b3, voffB); PG8_STAGE(PG8_SB(1, 1), b3 + hstep, voffB); PG8_STAGEA(PG8_SA(1, 0), o2, 0, k3);
            PG8_WAIT_V(8); PG8_WAIT_L(0); PG8_BAR; PG8_MMA(1, 0, At, B0); PG8_MMA(1, 1, At, B1); PG8_BAR; PG8_SCHED;
        }
        if (wr == 0) PG8_BAR;
        E(acc, cur, wr, wc, fr, fq);
        if (!has_next) break;
#pragma unroll
        for (int a = 0; a < 2; ++a)
#pragma unroll
            for (int b = 0; b < 2; ++b)
#pragma unroll
                for (int m = 0; m < 4; ++m)
#pragma unroll
                    for (int n = 0; n < 2; ++n) acc[a][b][m][n] = (f32x4){0.f, 0.f, 0.f, 0.f};
        cur = nxt; cB = nB; ++ui;
        if constexpr (Sched::GATHER) {
#pragma unroll
            for (int _h = 0; _h < 2; ++_h)
#pragma unroll
                for (int _i = 0; _i < 2; ++_i) cO[_h][_i] = nO[_h][_i];
        } else { PG8_AOFF(cO, cur); }
        if (wr == 1) PG8_BAR;
    }
    PG8_WAIT_V(0);
    PG8_BAR;
#undef PG8_SA
#undef PG8_SB
#undef PG8_STAGE
#undef PG8_STAGEA
#undef PG8_LDA
#undef PG8_LDB
#undef PG8_MMA
#undef PG8_WAIT_V
#undef PG8_WAIT_L
#undef PG8_BAR
#undef PG8_SCHED
#undef PG8_AOFF
#undef PG8_KA
#undef PG8_KB
}
}
__device__ __forceinline__ void transpose_item(const float* W, int N, bf16* WT, int ldt, int drow, int k0, int n0, LAS float* scr, int lane) {
    f32x4 v[8];
#pragma unroll
    for (int i = 0; i < 8; ++i) v[i] = *(const GAS f32x4*)(W + (size_t)(k0 + 8 * i + (lane >> 3)) * N + n0 + 4 * (lane & 7));
#pragma unroll
    for (int i = 0; i < 8; ++i) { LAS float* d = scr + (8 * i + (lane >> 3)) * 33 + 4 * (lane & 7); d[0] = v[i].x; d[1] = v[i].y; d[2] = v[i].z; d[3] = v[i].w; }
    LDS_WAIT(); asm volatile("" ::: "memory");
    const int c = lane & 7;
#pragma unroll
    for (int j = 0; j < 4; ++j) { const int n = (lane >> 3) + 8 * j; const LAS float* s = scr + (8 * c) * 33 + n;
        v4u o; o.x = pk2(s[0 * 33], s[1 * 33]); o.y = pk2(s[2 * 33], s[3 * 33]); o.z = pk2(s[4 * 33], s[5 * 33]); o.w = pk2(s[6 * 33], s[7 * 33]);
        *(GAS v4u*)(WT + (size_t)(drow + n) * ldt + k0 + 8 * c) = o; }
    LDS_WAIT(); asm volatile("" ::: "memory");
}
struct TrLoad { f32x4 v[8]; };
__device__ __forceinline__ void transpose_issue(TrLoad& t, const float* W, int N, int k0, int n0, int lane) {
#pragma unroll
    for (int i = 0; i < 8; ++i) t.v[i] = *(const GAS f32x4*)(W + (size_t)(k0 + 8 * i + (lane >> 3)) * N + n0 + 4 * (lane & 7));
}
__device__ __forceinline__ void transpose_finish(const TrLoad& t, bf16* WT, int ldt, int drow, int k0, LAS float* scr, int lane) {
#pragma unroll
    for (int i = 0; i < 8; ++i) { LAS float* d = scr + (8 * i + (lane >> 3)) * 33 + 4 * (lane & 7); d[0] = t.v[i].x; d[1] = t.v[i].y; d[2] = t.v[i].z; d[3] = t.v[i].w; }
    LDS_WAIT(); asm volatile("" ::: "memory");
    const int c = lane & 7;
#pragma unroll
    for (int j = 0; j < 4; ++j) { const int n = (lane >> 3) + 8 * j; const LAS float* s = scr + (8 * c) * 33 + n;
        v4u o; o.x = pk2(s[0 * 33], s[1 * 33]); o.y = pk2(s[2 * 33], s[3 * 33]); o.z = pk2(s[4 * 33], s[5 * 33]); o.w = pk2(s[6 * 33], s[7 * 33]);
        *(GAS v4u*)(WT + (size_t)(drow + n) * ldt + k0 + 8 * c) = o; }
    LDS_WAIT(); asm volatile("" ::: "memory");
}
__device__ __forceinline__ void rms_row_to_bf16(const float* xrow, const float* w, bf16* orow, int lane) {
    const GAS f32x4* xr = (const GAS f32x4*)xrow + lane; const GAS f32x4* wr = (const GAS f32x4*)w + lane;
    f32x4 v[4]; float s2 = 0.f;
#pragma unroll
    for (int j = 0; j < 4; ++j) { v[j] = xr[64 * j]; s2 += (v[j].x * v[j].x + v[j].y * v[j].y) + (v[j].z * v[j].z + v[j].w * v[j].w); }
    const float rstd = 1.f / sqrtf(wave_sum(s2) * (1.f / D) + NORM_EPS);
    GAS unsigned long long* o8 = (GAS unsigned long long*)orow + lane;
#pragma unroll
    for (int j = 0; j < 4; ++j) { const f32x4 g = wr[64 * j];
        o8[64 * j] = (unsigned long long)pk2(v[j].x * rstd * g.x, v[j].y * rstd * g.y) | ((unsigned long long)pk2(v[j].z * rstd * g.z, v[j].w * rstd * g.w) << 32); }
}
constexpr float ATT_C2 = 0.125f * 1.4426950408889634f;
__device__ __forceinline__ void qk_prepass_row(bf16* prow, int pos, bool do_q, const float* qnw, const float* knw, int lane) {
#pragma unroll
    for (int ps = 0; ps < 4; ++ps) {
        const bool isq = ps < 2;
        if (isq && !do_q) continue;
        const int col = ps * 512 + lane * 8, dl = (lane & 7) * 8;
        v4u raw = *(const GAS v4u*)(prow + col);
        float v[8]; v[0] = bflo(raw.x); v[1] = bfhi(raw.x); v[2] = bflo(raw.y); v[3] = bfhi(raw.y); v[4] = bflo(raw.z); v[5] = bfhi(raw.z); v[6] = bflo(raw.w); v[7] = bfhi(raw.w);
        float ss = 0.f;
#pragma unroll
        for (int j = 0; j < 8; ++j) ss += v[j] * v[j];
        ss += __shfl_xor(ss, 1); ss += __shfl_xor(ss, 2); ss += __shfl_xor(ss, 4);
        const float rstd = 1.f / sqrtf(ss * (1.f / 64.f) + NORM_EPS);
        const float* nw = isq ? qnw : knw;
#pragma unroll
        for (int j = 0; j < 8; ++j) v[j] = v[j] * rstd * nw[dl + j];
        float oth[8];
#pragma unroll
        for (int j = 0; j < 8; ++j) oth[j] = __shfl_xor(v[j], 1);
        if (dl < 16) {
#pragma unroll
            for (int j = 0; j < 8; ++j) {
                const float invf = expf(-13.122363377404328f * (float)j * 2.0f / 16.0f);
                float sn, cs; sincosf((float)pos * invf, &sn, &cs);
                v[j] = (dl == 0) ? (v[j] * cs - oth[j] * sn) : (v[j] * cs + oth[j] * sn);
            }
        }
        if (isq) {
#pragma unroll
            for (int j = 0; j < 8; ++j) v[j] *= ATT_C2;
        }
        v4u o; o.x = pk2(v[0], v[1]); o.y = pk2(v[2], v[3]); o.z = pk2(v[4], v[5]); o.w = pk2(v[6], v[7]);
        *(GAS v4u*)(prow + col) = o;
    }
}

namespace att {
constexpr int SLOTB = 32768, L_K0 = 0, L_K1 = 8192, L_V = 16384, L_WS = 65536, L_X = 67584, L_END = L_X + 65536;
static_assert(L_END <= LDSCTL_OFF, "attention LDS");
__device__ __forceinline__ int crow(int r, int hi) { return (r & 3) + 8 * (r >> 2) + 4 * hi; }
__device__ __forceinline__ int key_row(int b, int pos) { int s = pos - NMETA; s = s > SEQ - 1 ? SEQ - 1 : s; return pos < NMETA ? MX + pos : b * SEQ + s; }
__device__ __forceinline__ s16x4 vtr(LAS const unsigned char* p) { typedef short v4i16_t __attribute__((ext_vector_type(4)));
    return __builtin_bit_cast(s16x4, __builtin_amdgcn_ds_read_tr16_b64_v4i16((LAS v4i16_t*)p)); }
__device__ __forceinline__ unsigned cvtpk(float lo, float hi) { typedef __bf16 bf16x2_t __attribute__((ext_vector_type(2))); f32x2 v = {lo, hi}; bf16x2_t b = __builtin_convertvector(v, bf16x2_t); return __builtin_bit_cast(unsigned, b); }

__device__ __forceinline__ void unit(LAS unsigned char* lds, const bf16* PD, bf16* DO, int b, int h, int qb, float lam, const float* subw) {
    int tid_ = threadIdx.x; asm volatile("" : "+v"(tid_)); const int tid = tid_, lane = tid & 63, r32 = lane & 31, hi = lane >> 5; const int wid = __builtin_amdgcn_readfirstlane(tid >> 6);
    const int c = wid >> 2, wq = wid & 3;
    const int NT = 2 * qb + 3;
    const int qpos = NMETA + 128 * qb + 32 * wq + r32;
    bf16x8 qr[4];
    { const bf16* qp = PD + (size_t)(b * SEQ + 128 * qb + 32 * wq + r32) * DF_COLS + h * 128 + c * 64 + hi * 8;
#pragma unroll
      for (int d0 = 0; d0 < 4; ++d0) qr[d0] = *(const GAS bf16x8*)(qp + d0 * 16); }
    const int kp = wid, vp0i = wid, vp1i = wid + 8;
    v4u sk0, sk1, sv0, sv1;
    const bf16* kbase = PD + 1024 + h * 128 + kp * 8;
    const bf16* vbase0 = PD + 2048 + h * 128 + 32 * (vp0i >> 2) + (lane & 3) * 8;
    const bf16* vbase1 = PD + 2048 + h * 128 + 32 * (vp1i >> 2) + (lane & 3) * 8;
    const int kl = lane, vl0 = 16 * (vp0i & 3) + (lane >> 2), vl1 = 16 * (vp1i & 3) + (lane >> 2);
#define ATT_ROW(p) ((p) < NMETA ? MX + (p) : b * SEQ + ((p) - NMETA > SEQ - 1 ? SEQ - 1 : (p) - NMETA))
#define ATT_LOAD(t) do { const int pk = 64 * (t) + kl, pa = 64 * (t) + vl0, pb = 64 * (t) + vl1; const bf16* kr = kbase + (size_t)ATT_ROW(pk) * DF_COLS; \
        sk0 = *(const GAS v4u*)(kr); sk1 = *(const GAS v4u*)(kr + 64); \
        sv0 = *(const GAS v4u*)(vbase0 + (size_t)ATT_ROW(pa) * DF_COLS); sv1 = *(const GAS v4u*)(vbase1 + (size_t)ATT_ROW(pb) * DF_COLS); } while (0)
#define ATT_WRITE(slot) do { LAS unsigned char* sb_ = lds + (slot) * SLOTB; \
        *(LAS v4u*)(sb_ + L_K0 + kp * 1024 + lane * 16) = sk0; *(LAS v4u*)(sb_ + L_K1 + kp * 1024 + lane * 16) = sk1; \
        *(LAS v4u*)(sb_ + L_V + vp0i * 1024 + lane * 16) = sv0; *(LAS v4u*)(sb_ + L_V + vp1i * 1024 + lane * 16) = sv1; } while (0)
    LAS float* wsf = (LAS float*)(lds + L_WS) + wid * 64;
    f32x16 o[4];
#pragma unroll
    for (int i = 0; i < 4; ++i) o[i] = f32x16{};
    f32x16 negm = f32x16{};
    float mref = 0.f, lrun = 0.f;
    constexpr float THR = 6.0f;
    ATT_LOAD(0); ATT_WRITE(0);
    __syncthreads();
    for (int t = 0; t < NT; ++t) {
        if (t + 1 < NT) ATT_LOAD(t + 1);
        LAS const unsigned char* sb = lds + (t & 1) * SLOTB;
        f32x16 p0 = negm, p1 = negm;
        { LAS const unsigned char* kb = sb + (c ? L_K1 : L_K0) + hi * 1024 + r32 * 16;
#pragma unroll
          for (int d0 = 0; d0 < 4; ++d0) {
              const bf16x8 b0 = *(LAS const bf16x8*)(kb + d0 * 2048); const bf16x8 b1 = *(LAS const bf16x8*)(kb + d0 * 2048 + 512);
              p0 = __builtin_amdgcn_mfma_f32_32x32x16_bf16(b0, qr[d0], p0, 0, 0, 0); p1 = __builtin_amdgcn_mfma_f32_32x32x16_bf16(b1, qr[d0], p1, 0, 0, 0); } }
        if (64 * t + 63 > NMETA + 128 * qb + 32 * wq) {
#pragma unroll
            for (int r = 0; r < 16; ++r) { const int kv = 64 * t + crow(r, hi); if (kv > qpos) p0[r] = -INFINITY; if (kv + 32 > qpos) p1[r] = -INFINITY; }
        }
        float rm = fmaxf(p0[0], p1[0]);
#pragma unroll
        for (int r = 1; r < 16; ++r) rm = fmaxf(rm, fmaxf(p0[r], p1[r]));
        rm = fmaxf(rm, __shfl_xor(rm, 32));
        if (__any((t == 0) || (rm > THR))) {
            const float dl = (t == 0) ? rm : fmaxf(rm, 0.f);
            mref += dl;
#pragma unroll
            for (int r = 0; r < 16; ++r) { p0[r] -= dl; p1[r] -= dl; negm[r] = -mref; }
            const float f = __builtin_amdgcn_exp2f(-dl); lrun *= f;
            if (t > 0) {
                if (hi == 0) wsf[r32] = f;
                asm volatile("s_waitcnt lgkmcnt(0)" ::: "memory");
#pragma unroll
                for (int r = 0; r < 16; ++r) { const float fr_ = wsf[crow(r, hi)];
#pragma unroll
                    for (int d0 = 0; d0 < 4; ++d0) o[d0][r] *= fr_; }
            }
        }
        float sacc = 0.f;
#pragma unroll
        for (int r = 0; r < 16; ++r) { p0[r] = __builtin_amdgcn_exp2f(p0[r]); p1[r] = __builtin_amdgcn_exp2f(p1[r]); sacc += p0[r] + p1[r]; }
        lrun += sacc;
        v4u pw[4];
        pw[0] = (v4u){cvtpk(p0[0], p0[1]), cvtpk(p0[2], p0[3]), cvtpk(p0[4], p0[5]), cvtpk(p0[6], p0[7])};
        pw[1] = (v4u){cvtpk(p0[8], p0[9]), cvtpk(p0[10], p0[11]), cvtpk(p0[12], p0[13]), cvtpk(p0[14], p0[15])};
        pw[2] = (v4u){cvtpk(p1[0], p1[1]), cvtpk(p1[2], p1[3]), cvtpk(p1[4], p1[5]), cvtpk(p1[6], p1[7])};
        pw[3] = (v4u){cvtpk(p1[8], p1[9]), cvtpk(p1[10], p1[11]), cvtpk(p1[12], p1[13]), cvtpk(p1[14], p1[15])};
        { LAS const unsigned char* vb = sb + L_V + ((lane >> 4) & 1) * 32 + (lane & 3) * 8 + (4 * hi + ((lane & 15) >> 2)) * 64;
#pragma unroll
          for (int d0 = 0; d0 < 4; ++d0)
#pragma unroll
              for (int ks = 0; ks < 4; ++ks) {
                  const s16x4 lo = vtr(vb + d0 * 4096 + ks * 1024), hh = vtr(vb + d0 * 4096 + ks * 1024 + 512);
                  const bf16x8 vf = (bf16x8){lo[0], lo[1], lo[2], lo[3], hh[0], hh[1], hh[2], hh[3]};
                  o[d0] = __builtin_amdgcn_mfma_f32_32x32x16_bf16(__builtin_bit_cast(bf16x8, pw[ks]), vf, o[d0], 0, 0, 0); } }
        if (t + 1 < NT) ATT_WRITE((t + 1) & 1);
        __syncthreads();
    }
#undef ATT_LOAD
#undef ATT_WRITE
#undef ATT_ROW
    lrun += __shfl_xor(lrun, 32);
    if (hi == 0) wsf[32 + r32] = 1.0f / lrun;
    asm volatile("s_waitcnt lgkmcnt(0)" ::: "memory");
    float rli[16];
#pragma unroll
    for (int r = 0; r < 16; ++r) rli[r] = wsf[32 + crow(r, hi)];
    LAS float* X = (LAS float*)(lds + L_X) + wq * 4096;
    if (c == 1) {
#pragma unroll
        for (int d0 = 0; d0 < 4; ++d0)
#pragma unroll
            for (int r = 0; r < 16; ++r) X[(d0 * 16 + r) * 64 + lane] = o[d0][r] * rli[r];
    }
    __syncthreads();
    if (c == 0) {
        float ss[16];
#pragma unroll
        for (int r = 0; r < 16; ++r) { float s = 0.f;
#pragma unroll
            for (int d0 = 0; d0 < 4; ++d0) { const float v = o[d0][r] * rli[r] - lam * X[(d0 * 16 + r) * 64 + lane]; o[d0][r] = v; s += v * v; }
            ss[r] = s; }
#pragma unroll
        for (int r = 0; r < 16; ++r) {
#pragma unroll
            for (int off = 1; off < 32; off <<= 1) ss[r] += __shfl_xor(ss[r], off);
            ss[r] = 1.f / sqrtf(ss[r] * (1.f / 128.f) + NORM_EPS); }
        asm volatile("s_waitcnt lgkmcnt(0)" ::: "memory");
        LAS bf16* stg = (LAS bf16*)(lds + L_X + wq * 16384);
        float sw[4];
#pragma unroll
        for (int d0 = 0; d0 < 4; ++d0) sw[d0] = subw[32 * d0 + r32] * 0.8f;
#pragma unroll
        for (int r = 0; r < 16; ++r)
#pragma unroll
            for (int d0 = 0; d0 < 4; ++d0) stg[crow(r, hi) * 128 + 32 * d0 + r32] = (bf16)f2bf(o[d0][r] * ss[r] * sw[d0]);
    }
    __syncthreads();
    {
#pragma unroll
        for (int i = 0; i < 4; ++i) { const int id = tid + 512 * i, row = id >> 4, ch = id & 15;
            const v4u v = *(LAS const v4u*)(lds + L_X + (row >> 5) * 16384 + (row & 31) * 256 + ch * 16);
            *(GAS v4u*)(DO + (size_t)(b * SEQ + 128 * qb + row) * D + h * 128 + ch * 8) = v; }
    }
    __syncthreads();
}
}
namespace rk {
constexpr int LD64 = 72, LD128 = 136, LDF = 68;
constexpr int M64 = 64 * LD64 * 2  , M128 = 64 * LD128 * 2  , MF = 64 * LDF * 4  ;
constexpr int R1 = 0;
constexpr int O_TXW = R1, O_XA = R1 + M64, O_SXG = R1 + 2 * M64;
constexpr int O_LAB = R1, O_LAK = R1 + M64, O_LRB = R1 + 2 * M64, O_LRK = R1 + 3 * M64;
constexpr int R2 = R1 + 4 * M64;
constexpr int O_LC = R2, O_AA = R2 + MF;
constexpr int O_TL = R2, O_YS = R2 + M64, O_X1 = R2 + 2 * M64, O_AP = R2 + 3 * M64, O_WW = R2 + 4 * M64, O_YF = R2;
constexpr int FX = R2 + 5 * M64;
constexpr int O_AT = FX, O_BT = FX + M64, O_KT = FX + 2 * M64, O_RT = FX + 3 * M64, O_VM = FX + 4 * M64, O_GG = FX + 5 * M64, O_SB = FX + 6 * M64;
constexpr int O_LABD = FX + 7 * M64;
constexpr int O_SEG = O_LABD + 4352, O_BS = O_SEG + 2048, O_PCV = O_BS + 256, O_CONST = O_PCV + 256, O_END = O_CONST + 14 * 256;
static_assert(O_END <= LDSCTL_OFF && MF <= 2 * M64 && 2 * M64 + M128 <= 4 * M64 && 2 * MF <= 5 * M64, "rwkv LDS map");
enum { C_W0 = 0, C_A0, C_KK, C_KA, C_RK, C_LNW, C_LNB, C_MUR, C_MUK, C_MUV, C_MUW, C_MUA, C_MUG   };

typedef LAS unsigned char* lptr;
__device__ __forceinline__ bf16x8 ldA(lptr base, int ld, int m0, int k0, int lane) { return *(LAS const bf16x8*)(base + ((m0 + (lane & 15)) * ld + k0 + 8 * (lane >> 4)) * 2); }
__device__ __forceinline__ s16x4 vtr(lptr p) { typedef short v4i16_t __attribute__((ext_vector_type(4))); return __builtin_bit_cast(s16x4, __builtin_amdgcn_ds_read_tr16_b64_v4i16((LAS v4i16_t*)p)); }
__device__ __forceinline__ bf16x8 ldT(lptr base, int ld, int k0, int n0, int lane) {
    const int g = lane >> 4, q = (lane & 15) >> 2, p = lane & 3;
    lptr a = base + ((k0 + 8 * g + q) * ld + n0 + 4 * p) * 2;
    const s16x4 lo = vtr(a), hi = vtr(a + 4 * ld * 2);
    return (bf16x8){lo[0], lo[1], lo[2], lo[3], hi[0], hi[1], hi[2], hi[3]};
}
#define RK_MFMA(a, b, c) __builtin_amdgcn_mfma_f32_16x16x32_bf16((a), (b), (c), 0, 0, 0)
__device__ __forceinline__ void st16(lptr base, int ld, int m0, int n0, int lane, const f32x4& v) {
    LAS bf16* p = (LAS bf16*)base + (m0 + 4 * (lane >> 4)) * ld + n0 + (lane & 15);
#pragma unroll
    for (int i = 0; i < 4; ++i) p[i * ld] = (bf16)f2bf(v[i]);
}
__device__ __forceinline__ void unpack8(const v4u& w, float* f) { f[0] = bflo(w.x); f[1] = bfhi(w.x); f[2] = bflo(w.y); f[3] = bfhi(w.y); f[4] = bflo(w.z); f[5] = bfhi(w.z); f[6] = bflo(w.w); f[7] = bfhi(w.w); }
__device__ __forceinline__ v4u pack8(const float* f) { v4u o; o.x = pk2(f[0], f[1]); o.y = pk2(f[2], f[3]); o.z = pk2(f[4], f[5]); o.w = pk2(f[6], f[7]); return o; }
__device__ __forceinline__ void ldc8(lptr lds, int cidx, int off, float* f) { const f32x4 a = *(LAS const f32x4*)(lds + O_CONST + cidx * 256 + off * 4), b = *(LAS const f32x4*)(lds + O_CONST + cidx * 256 + off * 4 + 16);
    f[0] = a.x; f[1] = a.y; f[2] = a.z; f[3] = a.w; f[4] = b.x; f[5] = b.y; f[6] = b.z; f[7] = b.w; }

struct Params { const bf16* PR; bf16* RO; const float* mu; const float* w0; const float* a0; const float* kk; const float* ka; const float* rk; const float* lnw; const float* lnb; const bf16* W2T; const bf16* A2T; const bf16* G2T; };

__device__ __forceinline__ void run(lptr lds, const Params& P, int b, int h) {
    int tid = threadIdx.x, lane, wid, et, oct, g4, l15, mt, nt0;
#define RK_STAGE() do { asm volatile("" : "+v"(tid)); lane = tid & 63; wid = __builtin_amdgcn_readfirstlane(tid >> 6); et = tid >> 3; oct = tid & 7; g4 = lane >> 4; l15 = lane & 15; mt = wid >> 1; nt0 = 2 * (wid & 1); } while (0)
    RK_STAGE();
    if (tid < 64) { LAS float* C = (LAS float*)(lds + O_CONST); const int n = h * 64 + tid;
        C[C_W0 * 64 + tid] = P.w0[n]; C[C_A0 * 64 + tid] = P.a0[n]; C[C_KK * 64 + tid] = P.kk[n]; C[C_KA * 64 + tid] = P.ka[n]; C[C_RK * 64 + tid] = P.rk[n]; C[C_LNW * 64 + tid] = P.lnw[n]; C[C_LNB * 64 + tid] = P.lnb[n];
        C[C_MUR * 64 + tid] = P.mu[n]; C[C_MUK * 64 + tid] = P.mu[1024 + n]; C[C_MUV * 64 + tid] = P.mu[2048 + n]; C[C_MUW * 64 + tid] = P.mu[3072 + tid]; C[C_MUA * 64 + tid] = P.mu[3136 + tid];
        C[C_MUG * 64 + tid] = P.mu[3200 + tid]; C[C_MUG * 64 + 64 + tid] = P.mu[3264 + tid]; }
    for (int i = tid; i < M64 / 4; i += NTHREADS) ((LAS unsigned*)(lds + O_SB))[i] = 0u;
    bf16x8 wf[4];
    if (wid < 4) { const int n = h * 64 + 16 * wid + l15;
#pragma unroll
        for (int ks = 0; ks < 2; ++ks) { wf[ks] = *(const GAS bf16x8*)(P.W2T + (size_t)n * 64 + 32 * ks + 8 * g4); wf[2 + ks] = *(const GAS bf16x8*)(P.A2T + (size_t)n * 64 + 32 * ks + 8 * g4); } }
    else { const int n = h * 64 + 16 * (wid - 4) + l15;
#pragma unroll
        for (int ks = 0; ks < 4; ++ks) wf[ks] = *(const GAS bf16x8*)(P.G2T + (size_t)n * 128 + 32 * ks + 8 * g4); }
    f32x4 s0 = {0.f, 0.f, 0.f, 0.f}, s1 = {0.f, 0.f, 0.f, 0.f};
    __syncthreads();
    for (int c = 0; c <= 32; ++c) {
        RK_STAGE();
        const bool valid = (c > 0) || (et < NMETA);
        const int rowc = (c == 0) ? (MX + et) : (b * SEQ + 64 * (c - 1) + et);
        const bool hasprev = !(c == 0 && et == 0);
        const int rowp = (c == 1 && et == 0) ? (MX + NMETA - 1) : rowc - 1;
        float rr[8], kr[8], vr[8];
        {
            const bf16* pc = P.PR + (size_t)(valid ? rowc : MX) * RW_COLS; const bf16* pp = P.PR + (size_t)((valid && hasprev) ? rowp : MX) * RW_COLS;
            const float fv = valid ? 1.f : 0.f, fp = (valid && hasprev) ? 1.f : 0.f;
            v4u lc_[8], lp_[8];
            { const int co[8] = {h * 64 + 8 * oct, 1024 + h * 64 + 8 * oct, 2048 + h * 64 + 8 * oct, 3072 + 8 * oct, 3136 + 8 * oct, 3200 + 16 * oct, 3208 + 16 * oct, 0};
#pragma unroll
              for (int q = 0; q < 7; ++q) { lc_[q] = *(const GAS v4u*)(pc + co[q]); lp_[q] = *(const GAS v4u*)(pp + co[q]); } }
#define RK_LERP(dst, q, cidx, coff) do { float cu[8], pv[8], mm[8]; unpack8(lc_[q], cu); unpack8(lp_[q], pv); ldc8(lds, cidx, coff, mm); \
            _Pragma("unroll") for (int j = 0; j < 8; ++j) { const float c_ = cu[j] * fv; dst[j] = c_ + (pv[j] * fp - c_) * mm[j]; } } while (0)
            RK_LERP(rr, 0, C_MUR, 8 * oct); RK_LERP(kr, 1, C_MUK, 8 * oct); RK_LERP(vr, 2, C_MUV, 8 * oct);
            float xw[8], xa[8], xg0[8], xg1[8];
            RK_LERP(xw, 3, C_MUW, 8 * oct); RK_LERP(xa, 4, C_MUA, 8 * oct); RK_LERP(xg0, 5, C_MUG, 16 * oct); RK_LERP(xg1, 6, C_MUG, 16 * oct + 8);
#undef RK_LERP
#pragma unroll
            for (int j = 0; j < 8; ++j) { xw[j] = 1.0f - 2.0f * __builtin_amdgcn_rcpf(1.0f + __expf(2.0f * xw[j])); xg0[j] = __builtin_amdgcn_rcpf(1.0f + __expf(-xg0[j])); xg1[j] = __builtin_amdgcn_rcpf(1.0f + __expf(-xg1[j])); }
            *(LAS v4u*)(lds + O_TXW + (et * LD64 + 8 * oct) * 2) = pack8(xw);
            *(LAS v4u*)(lds + O_XA + (et * LD64 + 8 * oct) * 2) = pack8(xa);
            *(LAS v4u*)(lds + O_SXG + (et * LD128 + 16 * oct) * 2) = pack8(xg0);
            *(LAS v4u*)(lds + O_SXG + (et * LD128 + 16 * oct + 8) * 2) = pack8(xg1);
        }
        __syncthreads();
        RK_STAGE();
        if (wid < 4) {
            const int k = 16 * wid + l15; const float w0k = ((LAS const float*)(lds + O_CONST))[C_W0 * 64 + k], a0k = ((LAS const float*)(lds + O_CONST))[C_A0 * 64 + k];
#pragma unroll
            for (int m = 0; m < 4; ++m) {
                f32x4 aw = {0.f, 0.f, 0.f, 0.f}, aa = {0.f, 0.f, 0.f, 0.f};
#pragma unroll
                for (int ks = 0; ks < 2; ++ks) { aw = RK_MFMA(ldA(lds + O_TXW, LD64, 16 * m, 32 * ks, lane), wf[ks], aw); aa = RK_MFMA(ldA(lds + O_XA, LD64, 16 * m, 32 * ks, lane), wf[2 + ks], aa); }
#pragma unroll
                for (int i = 0; i < 4; ++i) { const int t = 16 * m + 4 * g4 + i;
                    ((LAS float*)(lds + O_LC))[t * LDF + k] = w0k + aw[i];
                    ((LAS float*)(lds + O_AA))[t * LDF + k] = a0k + aa[i]; }
            }
        } else {
            const int n0 = 16 * (wid - 4);
#pragma unroll
            for (int m = 0; m < 4; ++m) { f32x4 ag = {0.f, 0.f, 0.f, 0.f};
#pragma unroll
                for (int ks = 0; ks < 4; ++ks) ag = RK_MFMA(ldA(lds + O_SXG, LD128, 16 * m, 32 * ks, lane), wf[ks], ag);
                st16(lds + O_GG, LD64, 16 * m, n0, lane, ag); }
        }
        __syncthreads();
        RK_STAGE();
        float aa8[8];
        {
            LAS f32x4* lcp = (LAS f32x4*)(lds + O_LC + (et * LDF + 8 * oct) * 4); const LAS f32x4* aap = (const LAS f32x4*)(lds + O_AA + (et * LDF + 8 * oct) * 4);
            f32x4 w0_ = lcp[0], w1_ = lcp[1]; const f32x4 a0_ = aap[0], a1_ = aap[1];
            const float fvd = ((c > 0) || (et < NMETA)) ? -0.6065306597126334f : 0.f;
#pragma unroll
            for (int j = 0; j < 4; ++j) { w0_[j] = fvd * __builtin_amdgcn_rcpf(1.0f + __expf(-w0_[j])); w1_[j] = fvd * __builtin_amdgcn_rcpf(1.0f + __expf(-w1_[j]));
                aa8[j] = __builtin_amdgcn_rcpf(1.0f + __expf(-a0_[j])); aa8[4 + j] = __builtin_amdgcn_rcpf(1.0f + __expf(-a1_[j])); }
            lcp[0] = w0_; lcp[1] = w1_;
        }
        __syncthreads();
        RK_STAGE();
        { const int k = tid & 63, seg = tid >> 6; LAS float* LC = (LAS float*)(lds + O_LC); float run = 0.f;
#pragma unroll
          for (int j = 0; j < 8; ++j) { run += LC[(8 * seg + j) * LDF + k]; LC[(8 * seg + j) * LDF + k] = run; }
          ((LAS float*)(lds + O_SEG))[seg * 64 + k] = run;
          __syncthreads();
          float off = 0.f;
          for (int s2 = 0; s2 < seg; ++s2) off += ((LAS const float*)(lds + O_SEG))[s2 * 64 + k];
#pragma unroll
          for (int j = 0; j < 8; ++j) LC[(8 * seg + j) * LDF + k] += off; }
        __syncthreads();
        RK_STAGE();
        {
            float lc[8], lp[8], aa[8], ck[8];
            { const f32x4 a = *(LAS const f32x4*)(lds + O_LC + (et * LDF + 8 * oct) * 4), b2 = *(LAS const f32x4*)(lds + O_LC + (et * LDF + 8 * oct) * 4 + 16);
              lc[0] = a.x; lc[1] = a.y; lc[2] = a.z; lc[3] = a.w; lc[4] = b2.x; lc[5] = b2.y; lc[6] = b2.z; lc[7] = b2.w; }
            if (et > 0) { const f32x4 a = *(LAS const f32x4*)(lds + O_LC + ((et - 1) * LDF + 8 * oct) * 4), b2 = *(LAS const f32x4*)(lds + O_LC + ((et - 1) * LDF + 8 * oct) * 4 + 16);
              lp[0] = a.x; lp[1] = a.y; lp[2] = a.z; lp[3] = a.w; lp[4] = b2.x; lp[5] = b2.y; lp[6] = b2.z; lp[7] = b2.w; }
            else {
#pragma unroll
              for (int j = 0; j < 8; ++j) lp[j] = 0.f; }
#pragma unroll
            for (int j = 0; j < 8; ++j) aa[j] = aa8[j];
            ldc8(lds, C_KK, 8 * oct, ck);
            float kk[8], ss = 0.f;
#pragma unroll
            for (int j = 0; j < 8; ++j) { kk[j] = kr[j] * ck[j]; ss += kk[j] * kk[j]; }
            ss += __shfl_xor(ss, 1); ss += __shfl_xor(ss, 2); ss += __shfl_xor(ss, 4);
            const float rn = __builtin_amdgcn_rcpf(fmaxf(sqrtf(ss), 1e-12f));
            ldc8(lds, C_KA, 8 * oct, ck);
            float kp[8], at[8], bt[8], kt[8], rt[8];
#pragma unroll
            for (int j = 0; j < 8; ++j) { kk[j] *= rn; kp[j] = kr[j] * (1.0f + (aa[j] - 1.0f) * ck[j]);
                const float eP = __expf(lp[j]), eC = __expf(lc[j]), eN = __builtin_amdgcn_rcpf(eC);
                at[j] = -kk[j] * eP; bt[j] = kk[j] * aa[j] * eN; kt[j] = kp[j] * eN; rt[j] = rr[j] * eC;
                if (et == 63) ((LAS float*)(lds + O_PCV))[8 * oct + j] = eC; }
            ldc8(lds, C_RK, 8 * oct, ck);
            float bsum = 0.f;
#pragma unroll
            for (int j = 0; j < 8; ++j) bsum += rr[j] * kp[j] * ck[j];
            bsum += __shfl_xor(bsum, 1); bsum += __shfl_xor(bsum, 2); bsum += __shfl_xor(bsum, 4);
            if (oct == 0) ((LAS float*)(lds + O_BS))[et] = bsum;
            *(LAS v4u*)(lds + O_AT + (et * LD64 + 8 * oct) * 2) = pack8(at);
            *(LAS v4u*)(lds + O_BT + (et * LD64 + 8 * oct) * 2) = pack8(bt);
            *(LAS v4u*)(lds + O_KT + (et * LD64 + 8 * oct) * 2) = pack8(kt);
            *(LAS v4u*)(lds + O_RT + (et * LD64 + 8 * oct) * 2) = pack8(rt);
            *(LAS v4u*)(lds + O_VM + (et * LD64 + 8 * oct) * 2) = pack8(vr);
        }
        __syncthreads();
        RK_STAGE();
        { const v4u z4 = {0u, 0u, 0u, 0u}; for (int i = tid; i < 2 * M64 / 16; i += NTHREADS) *(LAS v4u*)(lds + O_TL + i * 16) = z4; }
        {
#pragma unroll
            for (int q = 0; q < 2; ++q) { const int nt = nt0 + q;
                f32x4 cab = {0.f, 0.f, 0.f, 0.f}, cak = cab, crb = cab, crk = cab;
                if (nt <= mt) {
#pragma unroll
                    for (int ks = 0; ks < 2; ++ks) { const bf16x8 fa = ldA(lds + O_AT, LD64, 16 * mt, 32 * ks, lane), fr = ldA(lds + O_RT, LD64, 16 * mt, 32 * ks, lane), fb = ldA(lds + O_BT, LD64, 16 * nt, 32 * ks, lane), fk = ldA(lds + O_KT, LD64, 16 * nt, 32 * ks, lane);
                        cab = RK_MFMA(fa, fb, cab); cak = RK_MFMA(fa, fk, cak); crb = RK_MFMA(fr, fb, crb); crk = RK_MFMA(fr, fk, crk); }
#pragma unroll
                    for (int i = 0; i < 4; ++i) { const int t = 16 * mt + 4 * g4 + i, ii = 16 * nt + l15; if (!(t > ii)) { cab[i] = 0.f; cak[i] = 0.f; } if (!(t >= ii)) { crb[i] = 0.f; crk[i] = 0.f; } }
                }
                st16(lds + O_LAB, LD64, 16 * mt, 16 * nt, lane, cab); st16(lds + O_LAK, LD64, 16 * mt, 16 * nt, lane, cak); st16(lds + O_LRB, LD64, 16 * mt, 16 * nt, lane, crb); st16(lds + O_LRK, LD64, 16 * mt, 16 * nt, lane, crk); }
        }
        __syncthreads();
        RK_STAGE();
        if (wid == 0) {
            { const int blk = g4, cc = l15; v4u Lr[16][2];
#pragma unroll
              for (int r = 1; r < 16; ++r) { Lr[r][0] = *(LAS const v4u*)(lds + O_LAB + ((16 * blk + r) * LD64 + 16 * blk) * 2); Lr[r][1] = *(LAS const v4u*)(lds + O_LAB + ((16 * blk + r) * LD64 + 16 * blk + 8) * 2); }
              float T[16];
#pragma unroll
              for (int r = 0; r < 16; ++r) { float acc = (r == cc) ? 1.f : 0.f;
#pragma unroll
                  for (int j = 0; j < r; ++j) { const unsigned w = Lr[r][j >> 3][(j >> 1) & 3]; const float lv = (j & 1) ? bfhi(w) : bflo(w); acc += lv * T[j]; }
                  T[r] = acc; }
#pragma unroll
              for (int r = 0; r < 16; ++r) ((LAS bf16*)(lds + O_TL))[(16 * blk + r) * LD64 + 16 * blk + cc] = (bf16)f2bf(T[r]); }
            asm volatile("s_waitcnt lgkmcnt(0)" ::: "memory");
            const f32x4 z = {0.f, 0.f, 0.f, 0.f};
#pragma unroll
            for (int pp = 0; pp < 2; ++pp) { const f32x4 y1 = RK_MFMA(ldA(lds + O_LAB, LD64, 32 * pp + 16, 32 * pp, lane), ldT(lds + O_TL, LD64, 32 * pp, 32 * pp, lane), z); st16(lds + O_YS, LD64, 32 * pp + 16, 32 * pp, lane, y1); }
            asm volatile("s_waitcnt lgkmcnt(0)" ::: "memory");
            f32x4 t21[2];
#pragma unroll
            for (int pp = 0; pp < 2; ++pp) t21[pp] = RK_MFMA(ldA(lds + O_TL, LD64, 32 * pp + 16, 32 * pp, lane), ldT(lds + O_YS, LD64, 32 * pp, 32 * pp, lane), z);
            asm volatile("s_waitcnt lgkmcnt(0)" ::: "memory");
#pragma unroll
            for (int pp = 0; pp < 2; ++pp) st16(lds + O_TL, LD64, 32 * pp + 16, 32 * pp, lane, t21[pp]);
            asm volatile("s_waitcnt lgkmcnt(0)" ::: "memory");
#pragma unroll
            for (int a = 0; a < 2; ++a)
#pragma unroll
                for (int bq = 0; bq < 2; ++bq) { const f32x4 y2 = RK_MFMA(ldA(lds + O_LAB, LD64, 32 + 16 * a, 0, lane), ldT(lds + O_TL, LD64, 0, 16 * bq, lane), z); st16(lds + O_YS, LD64, 32 + 16 * a, 16 * bq, lane, y2); }
            asm volatile("s_waitcnt lgkmcnt(0)" ::: "memory");
            f32x4 t2[2][2];
#pragma unroll
            for (int a = 0; a < 2; ++a)
#pragma unroll
                for (int bq = 0; bq < 2; ++bq) t2[a][bq] = RK_MFMA(ldA(lds + O_TL, LD64, 32 + 16 * a, 32, lane), ldT(lds + O_YS, LD64, 32, 16 * bq, lane), z);
            asm volatile("s_waitcnt lgkmcnt(0)" ::: "memory");
#pragma unroll
            for (int a = 0; a < 2; ++a)
#pragma unroll
                for (int bq = 0; bq < 2; ++bq) st16(lds + O_TL, LD64, 32 + 16 * a, 16 * bq, lane, t2[a][bq]);
        } else {
            for (int q = wid - 1; q < 16; q += 7) { const int m = q >> 2, n = q & 3; f32x4 acc = {0.f, 0.f, 0.f, 0.f};
#pragma unroll
                for (int ks = 0; ks < 2; ++ks) acc = RK_MFMA(ldA(lds + O_LAK, LD64, 16 * m, 32 * ks, lane), ldT(lds + O_VM, LD64, 32 * ks, 16 * n, lane), acc);
                st16(lds + O_X1, LD64, 16 * m, 16 * n, lane, acc); }
        }
        __syncthreads();
        RK_STAGE();
        f32x4 wl[2];
        {
            bf16x8 ft[2]; ft[0] = ldA(lds + O_TL, LD64, 16 * mt, 0, lane); ft[1] = ldA(lds + O_TL, LD64, 16 * mt, 32, lane);
#pragma unroll
            for (int q = 0; q < 2; ++q) { const int nt = nt0 + q; f32x4 ap = {0.f, 0.f, 0.f, 0.f}; wl[q] = ap;
#pragma unroll
                for (int ks = 0; ks < 2; ++ks) { ap = RK_MFMA(ft[ks], ldT(lds + O_AT, LD64, 32 * ks, 16 * nt, lane), ap); wl[q] = RK_MFMA(ft[ks], ldT(lds + O_X1, LD64, 32 * ks, 16 * nt, lane), wl[q]); }
                st16(lds + O_AP, LD64, 16 * mt, 16 * nt, lane, ap); }
        }
        __syncthreads();
        RK_STAGE();
        {
#pragma unroll
            for (int q = 0; q < 2; ++q) { const int nt = nt0 + q;
#pragma unroll
                for (int ks = 0; ks < 2; ++ks) wl[q] = RK_MFMA(ldA(lds + O_AP, LD64, 16 * mt, 32 * ks, lane), ldA(lds + O_SB, LD64, 16 * nt, 32 * ks, lane), wl[q]);
                st16(lds + O_WW, LD64, 16 * mt, 16 * nt, lane, wl[q]); }
        }
        __syncthreads();
        RK_STAGE();
        {
#pragma unroll
            for (int q = 0; q < 2; ++q) { const int nt = nt0 + q; f32x4 y = {0.f, 0.f, 0.f, 0.f};
#pragma unroll
                for (int ks = 0; ks < 2; ++ks) { y = RK_MFMA(ldA(lds + O_RT, LD64, 16 * mt, 32 * ks, lane), ldA(lds + O_SB, LD64, 16 * nt, 32 * ks, lane), y);
                    y = RK_MFMA(ldA(lds + O_LRK, LD64, 16 * mt, 32 * ks, lane), ldT(lds + O_VM, LD64, 32 * ks, 16 * nt, lane), y);
                    y = RK_MFMA(ldA(lds + O_LRB, LD64, 16 * mt, 32 * ks, lane), ldT(lds + O_WW, LD64, 32 * ks, 16 * nt, lane), y); }
                wl[q] = y; }
            f32x4 d0 = {0.f, 0.f, 0.f, 0.f}, d1 = d0;
#pragma unroll
            for (int ks = 0; ks < 2; ++ks) { const bf16x8 fw = ldT(lds + O_WW, LD64, 32 * ks, 16 * mt, lane), fv = ldT(lds + O_VM, LD64, 32 * ks, 16 * mt, lane);
                d0 = RK_MFMA(fw, ldT(lds + O_BT, LD64, 32 * ks, 16 * nt0, lane), d0); d0 = RK_MFMA(fv, ldT(lds + O_KT, LD64, 32 * ks, 16 * nt0, lane), d0);
                d1 = RK_MFMA(fw, ldT(lds + O_BT, LD64, 32 * ks, 16 * nt0 + 16, lane), d1); d1 = RK_MFMA(fv, ldT(lds + O_KT, LD64, 32 * ks, 16 * nt0 + 16, lane), d1); }
            const float pc0 = ((LAS const float*)(lds + O_PCV))[16 * nt0 + l15], pc1 = ((LAS const float*)(lds + O_PCV))[16 * nt0 + 16 + l15];
            s0 = (s0 + d0) * pc0; s1 = (s1 + d1) * pc1;
        }
        __syncthreads(); RK_STAGE();
        {
#pragma unroll
            for (int q = 0; q < 2; ++q) { LAS float* yp = (LAS float*)(lds + O_YF) + (16 * mt + 4 * g4) * LDF + 16 * (nt0 + q) + l15;
#pragma unroll
                for (int i = 0; i < 4; ++i) yp[i * LDF] = wl[q][i]; }
            st16(lds + O_SB, LD64, 16 * mt, 16 * nt0, lane, s0); st16(lds + O_SB, LD64, 16 * mt, 16 * nt0 + 16, lane, s1);
        }
        __syncthreads();
        RK_STAGE();
        if (c > 0) {
            float y[8], gg[8], lw[8], lb[8];
            { const f32x4 a = *(LAS const f32x4*)(lds + O_YF + (et * LDF + 8 * oct) * 4), b2 = *(LAS const f32x4*)(lds + O_YF + (et * LDF + 8 * oct) * 4 + 16);
              y[0] = a.x; y[1] = a.y; y[2] = a.z; y[3] = a.w; y[4] = b2.x; y[5] = b2.y; y[6] = b2.z; y[7] = b2.w; }
            float sm = 0.f;
#pragma unroll
            for (int j = 0; j < 8; ++j) sm += y[j];
            sm += __shfl_xor(sm, 1); sm += __shfl_xor(sm, 2); sm += __shfl_xor(sm, 4);
            const float mean = sm * (1.f / 64.f); float sv = 0.f;
#pragma unroll
            for (int j = 0; j < 8; ++j) { y[j] -= mean; sv += y[j] * y[j]; }
            sv += __shfl_xor(sv, 1); sv += __shfl_xor(sv, 2); sv += __shfl_xor(sv, 4);
            const float rstd = 1.0f / sqrtf(sv * (1.f / 64.f) + 64e-5f);
            { const v4u t_ = *(LAS const v4u*)(lds + O_GG + (et * LD64 + 8 * oct) * 2); unpack8(t_, gg); } ldc8(lds, C_LNW, 8 * oct, lw); ldc8(lds, C_LNB, 8 * oct, lb);
            const float bsv = ((LAS const float*)(lds + O_BS))[et];
            float o[8];
#pragma unroll
            for (int j = 0; j < 8; ++j) o[j] = (y[j] * rstd * lw[j] + lb[j] + bsv * vr[j]) * gg[j];
            *(GAS v4u*)(P.RO + (size_t)rowc * D + h * 64 + 8 * oct) = pack8(o);
        }
        __syncthreads();
    }
}
#undef RK_STAGE
}
constexpr int MOE_CAP = 40960, MOE_MAXT = 160;
constexpr int RW_CNT = CW_ROUTE, RW_CUR = CW_ROUTE + 64, RW_NT = CW_ROUTE + 128, RW_TE = CW_ROUTE + 192  ;
constexpr int RW_TOKK = 65536  , RW_GATE = RW_TOKK + MOE_CAP  ;
static_assert((RW_GATE + MOE_CAP) * 4 <= (int)CTL_ZERO_BYTES, "route tables inside CTL");
constexpr size_t WS_TE = WS_SMALL + 512 * 1024, WS_TG = WS_TE + 128 * 1024;

__device__ __forceinline__ float grp16_sum(float v) { v += __shfl_xor(v, 1); v += __shfl_xor(v, 2); v += __shfl_xor(v, 4); v += __shfl_xor(v, 8); return v; }
__device__ __forceinline__ void moe_row4(const float* h2, const float* n2w, bf16* xn2, const float* wg, const float* bg, const float* we, const float* be, int* te, float* tg, int mbase, LAS unsigned* hist, int lane) {
    const int l16 = lane & 15, m = mbase + (lane >> 4);
    const GAS f32x4* xr = (const GAS f32x4*)(h2 + (size_t)m * D) + l16; const GAS f32x4* wr = (const GAS f32x4*)n2w + l16;
    float s2 = 0.f;
#pragma unroll 1
    for (int c = 0; c < 2; ++c) { f32x4 v[8];
#pragma unroll
        for (int j = 0; j < 8; ++j) v[j] = xr[16 * (8 * c + j)];
#pragma unroll
        for (int j = 0; j < 8; ++j) s2 += (v[j].x * v[j].x + v[j].y * v[j].y) + (v[j].z * v[j].z + v[j].w * v[j].w); }
    const float rstd = 1.f / sqrtf(grp16_sum(s2) * (1.f / D) + NORM_EPS);
    GAS unsigned long long* o8 = (GAS unsigned long long*)(xn2 + (size_t)m * D) + l16;
    float lg[4] = {0.f, 0.f, 0.f, 0.f};
#pragma unroll 1
    for (int c = 0; c < 4; ++c) { f32x4 v[4], g[4], w4[4][4];
        const GAS f32x4* wgp = (const GAS f32x4*)wg + 4 * (l16 + 64 * c);
#pragma unroll
        for (int j = 0; j < 4; ++j) { v[j] = xr[16 * (4 * c + j)]; g[j] = wr[16 * (4 * c + j)]; }
#pragma unroll
        for (int j = 0; j < 4; ++j)
#pragma unroll
            for (int i = 0; i < 4; ++i) w4[j][i] = wgp[64 * j + i];
#pragma unroll
        for (int j = 0; j < 4; ++j) { v[j] = v[j] * rstd * g[j]; o8[16 * (4 * c + j)] = (unsigned long long)pk2(v[j].x, v[j].y) | ((unsigned long long)pk2(v[j].z, v[j].w) << 32);
#pragma unroll
            for (int i = 0; i < 4; ++i) { const float u = v[j][i]; lg[0] += u * w4[j][i].x; lg[1] += u * w4[j][i].y; lg[2] += u * w4[j][i].z; lg[3] += u * w4[j][i].w; } } }
#pragma unroll
    for (int q = 0; q < 4; ++q) lg[q] = grp16_sum(lg[q]) + bg[q];
    int gi = 0; float gm = lg[0];
#pragma unroll
    for (int q = 1; q < 4; ++q) if (lg[q] > gm) { gm = lg[q]; gi = q; }
    float gs = 0.f;
#pragma unroll
    for (int q = 0; q < 4; ++q) gs += __expf(lg[q] - gm);
    const float gval = 1.0f / gs;
    float le[8];
#pragma unroll
    for (int q = 0; q < 8; ++q) le[q] = 0.f;
#pragma unroll 1
    for (int c = 0; c < 8; ++c) { f32x4 v[2], g[2], wa[2][4], wb[2][4];
        const GAS f32x4* wep = (const GAS f32x4*)(we + (size_t)(4 * (l16 + 32 * c)) * 32 + gi * 8);
#pragma unroll
        for (int j = 0; j < 2; ++j) { v[j] = xr[16 * (2 * c + j)]; g[j] = wr[16 * (2 * c + j)]; }
#pragma unroll
        for (int j = 0; j < 2; ++j)
#pragma unroll
            for (int i = 0; i < 4; ++i) { wa[j][i] = wep[(64 * j + i) * 8]; wb[j][i] = wep[(64 * j + i) * 8 + 1]; }
#pragma unroll
        for (int j = 0; j < 2; ++j) { v[j] = v[j] * rstd * g[j];
#pragma unroll
            for (int i = 0; i < 4; ++i) { const float u = v[j][i]; const f32x4 a = wa[j][i], b = wb[j][i];
                le[0] += u * a.x; le[1] += u * a.y; le[2] += u * a.z; le[3] += u * a.w; le[4] += u * b.x; le[5] += u * b.y; le[6] += u * b.z; le[7] += u * b.w; } } }
#pragma unroll
    for (int q = 0; q < 8; ++q) le[q] = grp16_sum(le[q]) + be[gi * 8 + q];
    int i1 = 0; float m1 = le[0];
#pragma unroll
    for (int q = 1; q < 8; ++q) if (le[q] > m1) { m1 = le[q]; i1 = q; }
    int i2 = -1; float m2 = -INFINITY;
#pragma unroll
    for (int q = 0; q < 8; ++q) if (q != i1 && le[q] > m2) { m2 = le[q]; i2 = q; }
    const float p2 = __expf(m2 - m1), inv = 1.0f / (1.0f + p2);
    if (l16 == 0) { te[2 * m] = gi * 8 + i1; te[2 * m + 1] = gi * 8 + i2; tg[2 * m] = gval * inv; tg[2 * m + 1] = gval * p2 * inv;
        __hip_atomic_fetch_add(hist + gi * 8 + i1, 1u, __ATOMIC_RELAXED, __HIP_MEMORY_SCOPE_WORKGROUP); __hip_atomic_fetch_add(hist + gi * 8 + i2, 1u, __ATOMIC_RELAXED, __HIP_MEMORY_SCOPE_WORKGROUP); }
}

namespace pg8 {
struct LinearAOrder {
    static constexpr bool GATHER = false;
    StaticOrder so; unsigned rowbytes;
    __device__ bool next(int i, Unit& u) const { return so.next(i, u); }
    __device__ __forceinline__ unsigned a_row_off(const Unit& u, int r) const { return (unsigned)(u.pm * BM + r) * rowbytes; }
};
struct MoeOrder {
    static constexpr bool GATHER = true;
    const int* tokk; const unsigned* tile_e; int ntile, G, c; bool gather; unsigned rowbytes;
    __device__ bool next(int i, Unit& u) const { const long L = (long)i * G + c; if (L >= 4L * ntile) return false; const int tile = (int)(L >> 2); u.pm = tile; u.pn = (int)tile_e[tile] * 4 + (int)(L & 3); return true; }
    __device__ __forceinline__ unsigned a_row_off(const Unit& u, int r) const {
        if (gather) { const int idx = tokk[u.pm * BM + r]; const int tok = idx < 0 ? MX : (idx >> 1); return (unsigned)tok * rowbytes; }
        return (unsigned)(u.pm * BM + r) * rowbytes; }
};
struct EpiSwiGLU {
    static constexpr bool PERM = true, AFTER_DRAIN = false;
    bf16_t* H;
    __device__ __forceinline__ void operator()(const f32x4 (&acc)[2][2][4][2], const Unit& u, int wr, int wc, int fr, int fq) const {
        const int row0 = u.pm * BM + wr * 64 + fr, col0 = (u.pn & 3) * 128 + wc * 32 + 8 * fq;
#pragma unroll
        for (int ai = 0; ai < 2; ++ai)
#pragma unroll
            for (int m = 0; m < 4; ++m) { const size_t row = row0 + ai * HALF + m * 16; f32x4 h0, h1;
#pragma unroll
                for (int e = 0; e < 4; ++e) { const float g0 = acc[ai][0][m][0][e], g1 = acc[ai][0][m][1][e];
                    h0[e] = g0 / (1.0f + __expf(-g0)) * acc[ai][1][m][0][e]; h1[e] = g1 / (1.0f + __expf(-g1)) * acc[ai][1][m][1][e]; }
                u32x4 w; w.x = cvt_pk_bf16(h0[0], h0[1]); w.y = cvt_pk_bf16(h0[2], h0[3]); w.z = cvt_pk_bf16(h1[0], h1[1]); w.w = cvt_pk_bf16(h1[2], h1[3]);
                *(u32x4*)(H + row * 512 + col0) = w; }
    }
};
struct EpiMoeDown {
    static constexpr bool PERM = false, AFTER_DRAIN = false;
    const int* tokk; const float* gate; float* O; bf16_t* Y1;
    __device__ __forceinline__ void operator()(const f32x4 (&acc)[2][2][4][2], const Unit& u, int wr, int wc, int fr, int fq) const {
        const int slot0 = u.pm * BM + wr * 64 + fr, col0 = (u.pn & 3) * BM + wc * 32 + 4 * fq;
        int tk[2][4]; float gt[2][4];
#pragma unroll
        for (int ai = 0; ai < 2; ++ai)
#pragma unroll
            for (int m = 0; m < 4; ++m) { const int slot = slot0 + ai * HALF + m * 16; tk[ai][m] = tokk[slot]; gt[ai][m] = gate[slot]; }
#pragma unroll
        for (int ai = 0; ai < 2; ++ai) {
            f32x4 old[4][2][2];
#pragma unroll
            for (int m = 0; m < 4; ++m) { const bool s0 = (tk[ai][m] >= 0) && ((tk[ai][m] & 1) == 0); const size_t off = s0 ? (size_t)(tk[ai][m] >> 1) * 1024 + col0 : (size_t)col0;
#pragma unroll
                for (int bj = 0; bj < 2; ++bj)
#pragma unroll
                    for (int n = 0; n < 2; ++n) old[m][bj][n] = *(const f32x4*)(O + off + bj * HALF + n * 16); }
#pragma unroll
            for (int m = 0; m < 4; ++m) { const int t = tk[ai][m];
                if (t >= 0) { const float g = gt[ai][m]; const size_t off = (size_t)(t >> 1) * 1024 + col0;
                    if ((t & 1) == 0) {
#pragma unroll
                        for (int bj = 0; bj < 2; ++bj)
#pragma unroll
                            for (int n = 0; n < 2; ++n) *(f32x4*)(O + off + bj * HALF + n * 16) = old[m][bj][n] + acc[ai][bj][m][n] * g;
                    } else {
#pragma unroll
                        for (int bj = 0; bj < 2; ++bj)
#pragma unroll
                            for (int n = 0; n < 2; ++n) { const f32x4 v = acc[ai][bj][m][n] * g; unsigned long long w = (unsigned long long)cvt_pk_bf16(v[0], v[1]) | ((unsigned long long)cvt_pk_bf16(v[2], v[3]) << 32);
                                *(unsigned long long*)(Y1 + off + bj * HALF + n * 16) = w; }
                    } } }
            asm volatile("" ::: "memory");
        }
    }
};
}
#define KP_U ((bf16*)args.out)
#define KP_WinT ((bf16*)(args.ws + WS_WIN))
#define KP_PR ((bf16*)(args.ws + WS_PR))
#define KP_PD ((bf16*)(args.ws + WS_PD))
#define KP_PG ((bf16*)(args.ws + WS_PG))
#define KP_RO ((bf16*)args.out)
#define KP_DO ((bf16*)args.out + (size_t)MX * D)
#define KP_MRG ((bf16*)(args.ws + WS_MRG))
#define KP_XN2 ((bf16*)(args.ws + WS_XN2))
#define KP_WGU ((bf16*)(args.ws + WS_WGU))
#define KP_WDN ((bf16*)(args.ws + WS_WDN))
#define KP_HID ((bf16*)(args.ws + WS_HID))
#define KP_Y1 ((bf16*)(args.ws + WS_Y1))
#define KP_te ((int*)(args.ws + WS_TE))
#define KP_tg ((float*)(args.ws + WS_TG))
#define KP_tokk ((int*)(args.ws + WS_CTL) + RW_TOKK)
#define KP_rgate ((float*)(args.ws + WS_CTL) + RW_GATE)
struct Args { const float* in[33]; float* out; unsigned char* ws; int pad0, pad1; };
__global__ void __launch_bounds__(NTHREADS, 2) fwd_kernel(Args args) {
    extern __shared__ __attribute__((aligned(16))) unsigned char lds_raw[];
    LAS unsigned char* lds = (LAS unsigned char*)lds_raw;
    volatile LAS unsigned* MISC = (volatile LAS unsigned*)(lds + MISC_OFF);
    const int tid = threadIdx.x, lane = tid & 63, wave = __builtin_amdgcn_readfirstlane(tid >> 6);
    const int G = gridDim.x, bx = blockIdx.x; const int vcu = (G % 8 == 0) ? (bx % 8) * (G / 8) + bx / 8 : bx;
    unsigned char* ws = args.ws; gu32* ctl = (gu32*)(ws + WS_CTL);
    for (int u = tid; u < (LDS_BYTES - LDSCTL_OFF) / 4; u += NTHREADS) ((LAS unsigned*)(lds + LDSCTL_OFF))[u] = 0u;
    __syncthreads();
    XcdBarrier bar = xcd_barrier_post((unsigned*)(ctl + CW_BAR), MISC + 8);
    const float* x = args.in[0]; float* out = args.out;
#if defined(PROBE_A)
    unsigned long long* tsw = (unsigned long long*)(ws + WS_CTL + 12000); int n_ts = 0;
#define STAMP() do { if (bx == 0 && tid == 0) tsw[n_ts] = __builtin_amdgcn_s_memrealtime(); ++n_ts; } while (0)
#else
#define STAMP() do {} while (0)
#endif
    STAMP();
#ifndef REP_PHASE
#define REP_PHASE -1
#endif
#define NREP(k) ((REP_PHASE) == (k) ? 2 : 1)
    const int gw = vcu * NWAVES + wave, NGW = G * NWAVES;

    for (int rep_ = 0; rep_ < NREP(0); ++rep_) {
    {
        LAS float* scr = (LAS float*)(lds + wave * 16384);
        const float* Win = args.in[3];
        constexpr int I_IN = (D / 64) * (IN_COLS / 32);
        for (int it = gw; it < I_IN; it += NGW) { const int nblk = IN_COLS / 32, kb = it / nblk, nb = it % nblk; int drow = 32 * nb;
            { const int cq = 32 * nb - RW_COLS; if (cq >= 0 && cq < 2048) { const int within = cq & 255; drow = RW_COLS + (cq & ~255) + 128 * ((within >> 5) & 1) + 32 * (within >> 6); } }
            transpose_item(Win, IN_COLS, KP_WinT, D, drow, 64 * kb, 32 * nb, scr, lane); }
        { float* cs = (float*)(ws + WS_SMALL + 768 * 1024);
          for (int i = bx * NTHREADS + tid; i < (SEQ + NMETA) * 8; i += G * NTHREADS) { const int pos = i >> 3, j = i & 7; const float invf = expf(-13.122363377404328f * (float)j * 2.0f / 16.0f); float sn, csn; sincosf((float)pos * invf, &sn, &csn); cs[pos * 16 + j] = csn; cs[pos * 16 + 8 + j] = sn; } }
        { const float* Ws[3] = {args.in[22], args.in[23], args.in[24]}; bf16* Wd[3] = {(bf16*)(ws + WS_WBR), (bf16*)(ws + WS_WBD), (bf16*)(ws + WS_WOUT)};
          constexpr int I_SQ = (D / 64) * (D / 32);
#pragma unroll
          for (int w = 0; w < 3; ++w) for (int it = gw; it < I_SQ; it += NGW) { const int kb = it / 32, nb = it % 32; transpose_item(Ws[w], D, Wd[w], D, 32 * nb, 64 * kb, 32 * nb, scr, lane); } }
        { bf16* W2T = (bf16*)(ws + WS_SMALL); bf16* A2T = W2T + 1024 * 64; bf16* G2T = A2T + 1024 * 64;
          for (int it = gw; it < 128; it += NGW) { const int nb = it & 31, wsel = it >> 5;
              if (wsel == 0) transpose_item(args.in[6], 1024, W2T, 64, 32 * nb, 0, 32 * nb, scr, lane);
              else if (wsel == 1) transpose_item(args.in[8], 1024, A2T, 64, 32 * nb, 0, 32 * nb, scr, lane);
              else transpose_item(args.in[9], 1024, G2T, 128, 32 * nb, 64 * (wsel - 2), 32 * nb, scr, lane); } }
        const float* n1w = args.in[2];
        for (int m = gw; m < MPAD; m += NGW) {
            if (m < MX) rms_row_to_bf16(x + (size_t)m * D, n1w, KP_U + (size_t)m * D, lane);
            else if (m < MROWS) rms_row_to_bf16(args.in[1] + (size_t)(m - MX) * D, n1w, KP_U + (size_t)m * D, lane);
            else { GAS unsigned long long* o8 = (GAS unsigned long long*)(KP_U + (size_t)m * D) + lane;
#pragma unroll
                for (int j = 0; j < 4; ++j) o8[64 * j] = 0ull; }
        }
    }
    xcd_barrier(bar); STAMP();
    }
    for (int rep_ = 0; rep_ < NREP(1); ++rep_) {
    {
        pg8::Gemm g{KP_U, KP_WinT, MPAD, IN_COLS, D}; pg8::InProjOrder S; S.init(G, bx);
        pg8::EpiInProj E{KP_PR, KP_PD, KP_PG, args.in[15], args.in[16], (const float*)(ws + WS_SMALL + 768 * 1024)};
        pg8::gemm_phase<pg8::EpiInProj, pg8::InProjOrder, true, true>(lds, g, S, E);
    }
    xcd_barrier(bar); STAMP();
    }
    if (REP_PHASE == 9) { for (int r9 = 0; r9 < 10; ++r9) xcd_barrier(bar); }
    for (int rep_ = 0; rep_ < NREP(2); ++rep_) {
    {
        if (vcu < 128) {
            rk::Params RP{KP_PR, KP_RO, args.in[4], args.in[5], args.in[7], args.in[10], args.in[11], args.in[12], args.in[13], args.in[14], (const bf16*)(ws + WS_SMALL), (const bf16*)(ws + WS_SMALL) + 1024 * 64, (const bf16*)(ws + WS_SMALL) + 2 * 1024 * 64};
            rk::run(lds, RP, vcu >> 4, vcu & 15);
            if (REP_PHASE == 20) rk::run(lds, RP, vcu >> 4, vcu & 15);
#if defined(PROBE_A)
            if (vcu == 0 && tid == 0) tsw[30] = __builtin_amdgcn_s_memrealtime();
#endif
        }
        float lam;
        { const float a1 = args.in[17][lane] * args.in[18][lane], a2 = args.in[19][lane] * args.in[20][lane]; lam = expf(wave_sum(a1)) - expf(wave_sum(a2)) + 0.2f; }
        for (;;) {
            if (tid == 0) MISC[0] = __hip_atomic_fetch_add(ctl + CW_QUEUE + 64 * rep_, 1u, RLX_AGENT);
            __syncthreads();
            const int idx = (int)MISC[0];
            __syncthreads();
            if (idx >= 1024) break;
            const int qb = 15 - (idx >> 6), bh = idx & 63;
            att::unit(lds, KP_PD, KP_DO, bh >> 3, bh & 7, qb, lam, args.in[21]);
        }
    }
    xcd_barrier(bar); STAMP();
    }
    if (REP_PHASE == 21) {
        float lam;
        { const float a1 = args.in[17][lane] * args.in[18][lane], a2 = args.in[19][lane] * args.in[20][lane]; lam = expf(wave_sum(a1)) - expf(wave_sum(a2)) + 0.2f; }
        for (;;) {
            if (tid == 0) MISC[0] = __hip_atomic_fetch_add(ctl + CW_QUEUE + 128, 1u, RLX_AGENT);
            __syncthreads();
            const int idx = (int)MISC[0];
            __syncthreads();
            if (idx >= 1024) break;
            const int qb = 15 - (idx >> 6), bh = idx & 63;
            att::unit(lds, KP_PD, KP_DO, bh >> 3, bh & 7, qb, lam, args.in[21]);
        }
        xcd_barrier(bar);
    }
    {
        pg8::Gemm g{KP_RO, (const bf16*)(ws + WS_WBR), 2 * MX, 2 * D, D}; pg8::BranchOrder S; S.so.init(MX, D, G, bx);
        pg8::EpiBranch E{KP_PG, KP_HID, KP_MRG};
        pg8::gemm_phase<pg8::EpiBranch, pg8::BranchOrder, true, true>(lds, g, S, E);
    }
    xcd_barrier(bar); STAMP();
    for (int rep_ = 0; rep_ < NREP(4); ++rep_) {
    {
        pg8::Gemm g{KP_MRG, (const bf16*)(ws + WS_WOUT), MX, D, D}; pg8::StaticOrder S; S.init(MX, D, G, bx);
        pg8::EpiResF32 E{x, out};
        pg8::gemm_phase<pg8::EpiResF32, pg8::StaticOrder, true, true>(lds, g, S, E);
    }
    xcd_barrier(bar); STAMP();
    }
    {
        LAS unsigned* hist = (LAS unsigned*)(lds + 131072);
        if (tid < 32) hist[tid] = 0u;
        __syncthreads();
        for (int i = bx * NTHREADS + tid; i < MOE_CAP; i += G * NTHREADS) KP_tokk[i] = -1;
        if (bx == 0) ((GAS unsigned*)(KP_XN2 + (size_t)MX * D))[tid] = 0u;
        LAS float* scr = (LAS float*)(lds + wave * 16384);
        for (int rp5 = 0; rp5 < NREP(5); ++rp5) { if (rp5) hist += 64;
            for (int w4 = gw; w4 < MX / 4; w4 += NGW) moe_row4(out, args.in[25], KP_XN2, args.in[26], args.in[27], args.in[28], args.in[29], KP_te, KP_tg, 4 * w4, hist, lane);
            LAS float* scr = (LAS float*)(lds + wave * 16384);
            for (int it = gw; it < 24576; it += NGW) {
                if (it < 16384) { const int up = it >> 13, r = it & 8191, e = r >> 8, q = r & 255, kb = q >> 4, nb = q & 15, n0 = 32 * nb;
                    transpose_item(args.in[30 + up] + (size_t)e * 524288, 512, KP_WGU, 1024, e * 1024 + (n0 >> 7) * 256 + up * 128 + (n0 & 127), 64 * kb, n0, scr, lane); }
                else { const int r = it - 16384, e = r >> 8, q = r & 255, kb = q >> 5, nb = q & 31;
                    transpose_item(args.in[32] + (size_t)e * 524288, 1024, KP_WDN, 512, e * 1024 + 32 * nb, 64 * kb, 32 * nb, scr, lane); }
            }
        }
        __syncthreads();
        if (NREP(5) == 2) hist -= 64;
        if (tid < 32) __hip_atomic_fetch_add(ctl + RW_CNT + tid, hist[tid], RLX_AGENT);
    }
    xcd_barrier(bar); STAMP();
    {
        LAS unsigned* st = (LAS unsigned*)(lds + 131072);
        if (tid == 0) { unsigned run = 0u;
            for (int e = 0; e < NEXP; ++e) { const unsigned cn = __hip_atomic_load(ctl + RW_CNT + e, RLX_AGENT); st[e] = run; const unsigned nt_ = (cn + 255u) >> 8;
                if (bx == 0) for (unsigned j = 0; j < nt_; ++j) __hip_atomic_store(ctl + RW_TE + (run >> 8) + j, (unsigned)e, RLX_AGENT);
                run += nt_ << 8; }
            if (bx == 0) __hip_atomic_store(ctl + RW_NT, run >> 8, RLX_AGENT); }
        __syncthreads();
        if (lane < 16) { const int m = gw + NGW * (lane >> 1), a = lane & 1;
            if (m < MX) { const int e = KP_te[2 * m + a]; const unsigned pos = __hip_atomic_fetch_add(ctl + RW_CUR + e, 1u, RLX_AGENT); const unsigned slot = st[e] + pos;
                KP_tokk[slot] = 2 * m + a; KP_rgate[slot] = KP_tg[2 * m + a]; } }
    }
    xcd_barrier(bar); STAMP();
    const int ntile = (int)__hip_atomic_load(ctl + RW_NT, RLX_AGENT);
    for (int rep_ = 0; rep_ < NREP(6); ++rep_) {
    {
        pg8::Gemm g{KP_XN2, KP_WGU, 0, 0, D}; pg8::MoeOrder S{KP_tokk, (const unsigned*)(ws + WS_CTL) + RW_TE, ntile, G, vcu, true, 2048u};
        pg8::EpiSwiGLU E{KP_HID};
        pg8::gemm_phase_g<pg8::EpiSwiGLU, pg8::MoeOrder>(lds, g, S, E);
    }
    xcd_barrier(bar); STAMP();
    }
    {
        pg8::Gemm g{KP_HID, KP_WDN, 0, 0, EFF}; pg8::MoeOrder S{KP_tokk, (const unsigned*)(ws + WS_CTL) + RW_TE, ntile, G, vcu, false, 1024u};
        pg8::EpiMoeDown E{KP_tokk, KP_rgate, out, KP_Y1};
        pg8::gemm_phase_g<pg8::EpiMoeDown, pg8::MoeOrder>(lds, g, S, E);
    }
    xcd_barrier(bar); STAMP();
    {
        for (int m = gw; m < MX; m += NGW) {
            GAS f32x4* o = (GAS f32x4*)(out + (size_t)m * D) + lane; const GAS v2u* y = (const GAS v2u*)(KP_Y1 + (size_t)m * D) + lane;
#pragma unroll
            for (int j = 0; j < 4; ++j) { const v2u w = y[64 * j]; f32x4 v = o[64 * j]; v.x += bflo(w.x); v.y += bfhi(w.x); v.z += bflo(w.y); v.w += bfhi(w.y);
                o[64 * j] = v; }
        }
    }
}

extern "C" void kernel_launch(void* const* d_in, const int* in_sizes, int n_in, void* d_out, int out_size, void* d_ws, size_t ws_size, hipStream_t stream) {
    static int grid = 0;
    if (grid == 0) {
        if (n_in != 33 || out_size != MX * D || ws_size < WS_END) { fprintf(stderr, "kernel_launch: unexpected shapes n_in %d out %d ws %zu\n", n_in, out_size, ws_size); grid = -1; return; }
        int dev = 0, cus = 0;
        if (hipGetDevice(&dev) != hipSuccess || hipDeviceGetAttribute(&cus, hipDeviceAttributeMultiprocessorCount, dev) != hipSuccess) { grid = -1; return; }
        if (hipFuncSetAttribute((const void*)fwd_kernel, hipFuncAttributeMaxDynamicSharedMemorySize, LDS_BYTES) != hipSuccess) { fprintf(stderr, "kernel_launch: hipFuncSetAttribute failed\n"); grid = -1; return; }
        int per_cu = 0;
        if (hipOccupancyMaxActiveBlocksPerMultiprocessor(&per_cu, (const void*)fwd_kernel, NTHREADS, LDS_BYTES) != hipSuccess || per_cu < 1) fprintf(stderr, "kernel_launch: occupancy query says %d\n", per_cu);
        (void)hipGetLastError();
        grid = cus;
    }
    if (grid < 0) return;
    (void)hipMemsetAsync((char*)d_ws + WS_CTL, 0, CTL_ZERO_BYTES, stream);
    Args a{};
    for (int i = 0; i < 33; ++i) a.in[i] = (const float*)d_in[i];
    a.out = (float*)d_out; a.ws = (unsigned char*)d_ws;
    hipLaunchKernelGGL(fwd_kernel, dim3(grid), dim3(NTHREADS), LDS_BYTES, stream, a);
}
```

```cpp
#include <hip/hip_runtime.h>
#include <cstdio>
#include <cstdint>
#include <cmath>
#ifndef REP_PHASE
#define REP_PHASE -1
#endif
constexpr int D = 1024, NB = 8, SEQ = 2048, NMETA = 16, MX = NB * SEQ  , MROWS = MX + NMETA  , MPAD = MX + 256;
constexpr int RW_COLS = 3328, DF_COLS = 3072, GT_COLS = 2048, IN_COLS = RW_COLS + DF_COLS + GT_COLS;
constexpr int NEXP = 32, EFF = 512;
constexpr float NORM_EPS = 1e-6f;
constexpr size_t MiB = 1u << 20;
constexpr size_t WS_CTL = 0, CTL_ZERO_BYTES = 1 * MiB;
constexpr size_t WS_SMALL = 1 * MiB;
constexpr size_t WS_WBR = 2 * MiB, WS_WBD = 4 * MiB, WS_WOUT = 6 * MiB;
constexpr size_t WS_WIN = 8 * MiB;
constexpr size_t WS_PG = 25 * MiB;
constexpr size_t WS_PR = 89 * MiB;
constexpr size_t WS_PD = 194 * MiB;
constexpr size_t WS_END = 291 * MiB;
static_assert(WS_WIN + (size_t)IN_COLS * D * 2 <= WS_PG && WS_PG + (size_t)MX * GT_COLS * 2 <= WS_PR && WS_PR + (size_t)MROWS * RW_COLS * 2 <= WS_PD && WS_PD + (size_t)MROWS * DF_COLS * 2 <= WS_END, "ws map");
constexpr size_t WS_MRG = 89 * MiB;
constexpr size_t WS_XN2 = 121 * MiB;
constexpr size_t WS_WGU = 154 * MiB;
constexpr size_t WS_WDN = 218 * MiB;
constexpr size_t WS_HID = 250 * MiB;
constexpr size_t WS_Y1 = 25 * MiB;
constexpr int CW_TMO = 0, CW_CODE = 1, CW_BAR = 4096, CW_QUEUE = 16384, CW_ROUTE = 32768;
namespace pg8 {
#define PG8_LAS __attribute__((address_space(3)))
typedef unsigned short bf16_t;
typedef short bf16x8 __attribute__((ext_vector_type(8)));
typedef float f32x4 __attribute__((ext_vector_type(4)));
typedef unsigned u32x4 __attribute__((ext_vector_type(4)));
constexpr int BM = 256, BK = 64, HALF = 128, HTB = HALF * BK * 2  , STAGE_BYTES = 8 * HTB, NXCD = 8, WGM = 4;

__host__ __device__ __forceinline__ int lds_byte(int r, int c) { const int st = (r >> 4) * 2 + (c >> 5), rr = r & 15, cc = c & 31, ob = rr * 64 + cc * 2; return st * 1024 + (ob ^ (((ob >> 9) & 1) << 5)); }
__host__ __device__ __forceinline__ void stage_rc(int b, int& R, int& C) { const int st = b / 1024, sb = b % 1024, swz = sb ^ (((sb >> 9) & 1) << 5); R = (st >> 1) * 16 + swz / 64; C = (st & 1) * 32 + (swz % 64) / 2; }
__host__ __device__ __forceinline__ int perm32(int rho) { const int n = rho >> 4, i = rho & 15; return 8 * (i >> 2) + 4 * n + (i & 3); }

struct Unit { int pm, pn; };
struct Gemm { const bf16_t* A; const bf16_t* Bt; int M, N, K; };

struct StaticOrder {
    int nM, nN, nwg, G, c;
    __host__ __device__ void init(int M, int N, int G_, int c_) { nM = M / BM; nN = N / BM; nwg = nM * nN; G = G_; c = c_; }
    __host__ __device__ bool next(int i, Unit& u) const {
        const long L = (long)i * G + c; if (L >= nwg) return false;
        int wgid = (int)L; { const int q = nwg / NXCD, r = nwg % NXCD, xcd = wgid % NXCD, off = wgid / NXCD; wgid = (xcd < r ? xcd * (q + 1) : r * (q + 1) + (xcd - r) * q) + off; }
        const int nig = WGM * nN, gid = wgid / nig, fm = gid * WGM, gsz = (nM - fm) < WGM ? (nM - fm) : WGM;
        u.pm = fm + ((wgid % nig) % gsz); u.pn = (wgid % nig) / gsz; return true;
    }
    __device__ __forceinline__ void a_ready(const Unit&) const {}
    __device__ __forceinline__ void done(const Unit&) const {}
};

__device__ __forceinline__ unsigned cvt_pk_bf16(float lo, float hi) { unsigned r; asm volatile("v_cvt_pk_bf16_f32 %0, %1, %2" : "=v"(r) : "v"(lo), "v"(hi)); return r; }
typedef float f32x2 __attribute__((ext_vector_type(2)));
template <class Epi, class Sched, bool ALIGN_EPI = false, bool SP2 = false>
__device__ __forceinline__ void gemm_phase(PG8_LAS unsigned char* lds, const Gemm g, const Sched& S, const Epi& E) {
    int tid_ = threadIdx.x; asm volatile("" : "+v"(tid_)); const int tid = tid_, wid = __builtin_amdgcn_readfirstlane(tid >> 6), lane = tid & 63, wr = wid >> 2, wc = wid & 3, fr = lane & 15, fq = lane >> 4;
    const int K = g.K, nt = K / BK;
    unsigned voffA[2], voffB[2];
#pragma unroll
    for (int i = 0; i < 2; ++i) { int R, C; stage_rc(tid * 16 + i * 8192, R, C); const int Rb = Epi::PERM ? ((R & ~31) + perm32(R & 31)) : R;
        voffA[i] = (unsigned)(R * K + C) * 2u; voffB[i] = (unsigned)(Rb * K + C) * 2u; }
    const size_t kstep = (size_t)(BK * 2);
    const size_t hstep = (size_t)HALF * K * 2;
    const size_t tstep = 2 * hstep;
    const unsigned ldsw = (unsigned)wid * 1024u;
    const int aoff = lds_byte(wr * 64 + fr, fq * 8), boff = lds_byte(wc * 32 + fr, fq * 8);
#define PG8_SA(b, h) (((b) * 2 + (h)) * HTB)
#define PG8_SB(b, h) ((4 + (b) * 2 + (h)) * HTB)
#define PG8_STAGE(bufoff, gbase, voff) do { _Pragma("unroll") for (int _i = 0; _i < 2; ++_i) \
        __builtin_amdgcn_global_load_lds((const unsigned*)((const char*)(gbase) + (voff)[_i]), (PG8_LAS unsigned*)(lds + (bufoff) + ldsw + _i * 8192), 16, 0, 0); } while (0)
#define PG8_LDA(dst, b, h) do { _Pragma("unroll") for (int m = 0; m < 4; ++m) _Pragma("unroll") for (int k = 0; k < 2; ++k) dst[m][k] = *(const PG8_LAS bf16x8*)(lds + PG8_SA(b, h) + aoff + m * 2048 + k * 1024); } while (0)
#define PG8_LDB(dst, b, h) do { _Pragma("unroll") for (int n = 0; n < 2; ++n) _Pragma("unroll") for (int k = 0; k < 2; ++k) dst[n][k] = *(const PG8_LAS bf16x8*)(lds + PG8_SB(b, h) + boff + n * 2048 + k * 1024); } while (0)
#define PG8_MMA(ai, bj, At, Bt) do { __builtin_amdgcn_s_setprio(1); _Pragma("unroll") for (int m = 0; m < 4; ++m) _Pragma("unroll") for (int n = 0; n < 2; ++n) _Pragma("unroll") for (int k = 0; k < 2; ++k) \
        acc[ai][bj][m][n] = __builtin_amdgcn_mfma_f32_16x16x32_bf16(Bt[n][k], At[m][k], acc[ai][bj][m][n], 0, 0, 0); __builtin_amdgcn_s_setprio(0); } while (0)
#define PG8_WAIT_V(n) asm volatile("s_waitcnt vmcnt(" #n ")" ::: "memory")
#define PG8_WAIT_L(n) asm volatile("s_waitcnt lgkmcnt(" #n ")" ::: "memory")
#define PG8_BAR __builtin_amdgcn_s_barrier()
#define PG8_SCHED __builtin_amdgcn_sched_barrier(0)
    Unit cur, nxt; int ui = 0;
    if (!S.next(0, cur)) return;
    f32x4 acc[2][2][4][2];
#pragma unroll
    for (int a = 0; a < 2; ++a)
#pragma unroll
        for (int b = 0; b < 2; ++b)
#pragma unroll
            for (int m = 0; m < 4; ++m)
#pragma unroll
                for (int n = 0; n < 2; ++n) acc[a][b][m][n] = (f32x4){0.f, 0.f, 0.f, 0.f};
    bf16x8 At[4][2], B0[2][2], B1[2][2];
    const char* cA = (const char*)g.A + (size_t)cur.pm * tstep; const char* cB = (const char*)g.Bt + (size_t)cur.pn * tstep;
    S.a_ready(cur);
    if constexpr (SP2) {
        PG8_STAGE(PG8_SB(0, 0), cB, voffB); PG8_STAGE(PG8_SB(0, 1), cB + hstep, voffB); PG8_STAGE(PG8_SA(0, 0), cA, voffA); PG8_STAGE(PG8_SA(0, 1), cA + hstep, voffA);
        if (wr == 1) PG8_BAR;
        PG8_WAIT_V(2); PG8_BAR;
        PG8_STAGE(PG8_SB(1, 0), cB + kstep, voffB); PG8_STAGE(PG8_SA(1, 0), cA + kstep, voffA); PG8_STAGE(PG8_SB(1, 1), cB + hstep + kstep, voffB);
        PG8_WAIT_V(6); PG8_BAR;
    } else {
        PG8_STAGE(PG8_SB(0, 0), cB, voffB); PG8_STAGE(PG8_SA(0, 0), cA, voffA); PG8_STAGE(PG8_SB(0, 1), cB + hstep, voffB); PG8_STAGE(PG8_SA(0, 1), cA + hstep, voffA);
        if (wr == 1) PG8_BAR;
        PG8_WAIT_V(4); PG8_BAR;
        PG8_STAGE(PG8_SB(1, 0), cB + kstep, voffB); PG8_STAGE(PG8_SA(1, 0), cA + kstep, voffA); PG8_STAGE(PG8_SB(1, 1), cB + hstep + kstep, voffB);
        PG8_WAIT_V(6); PG8_BAR;
    }
    for (;;) {
        const bool has_next = S.next(ui + 1, nxt);
        const char* nA = has_next ? (const char*)g.A + (size_t)nxt.pm * tstep : cA; const char* nB = has_next ? (const char*)g.Bt + (size_t)nxt.pn * tstep : cB;
        for (int t = 0; t < nt; t += 2) {
            const bool last = (t == nt - 2);
            const char* a1 = cA + (size_t)(t + 1) * kstep;
            const char* a2 = last ? nA : cA + (size_t)(t + 2) * kstep; const char* b2 = last ? nB : cB + (size_t)(t + 2) * kstep;
            const char* a3 = a2 + kstep; const char* b3 = b2 + kstep;
            if (last && has_next) S.a_ready(nxt);
            if constexpr (SP2) {
            PG8_LDB(B0, 0, 0); PG8_LDB(B1, 0, 1); PG8_SCHED; PG8_LDA(At, 0, 0); PG8_STAGE(PG8_SA(1, 1), a1 + hstep, voffA);
            PG8_WAIT_V(8); PG8_WAIT_L(0); PG8_BAR; PG8_MMA(0, 0, At, B0); PG8_MMA(0, 1, At, B1); PG8_BAR; PG8_SCHED;
            PG8_LDA(At, 0, 1); PG8_STAGE(PG8_SB(0, 0), b2, voffB); PG8_STAGE(PG8_SB(0, 1), b2 + hstep, voffB); PG8_STAGE(PG8_SA(0, 0), a2, voffA);
            PG8_WAIT_V(8); PG8_WAIT_L(0); PG8_BAR; PG8_MMA(1, 0, At, B0); PG8_MMA(1, 1, At, B1); PG8_BAR; PG8_SCHED;
            PG8_LDB(B0, 1, 0); PG8_LDB(B1, 1, 1); PG8_SCHED; PG8_LDA(At, 1, 0); PG8_STAGE(PG8_SA(0, 1), a2 + hstep, voffA);
            PG8_WAIT_V(8); PG8_WAIT_L(0); PG8_BAR; PG8_MMA(0, 0, At, B0); PG8_MMA(0, 1, At, B1); PG8_BAR; PG8_SCHED;
            PG8_LDA(At, 1, 1); PG8_STAGE(PG8_SB(1, 0), b3, voffB); PG8_STAGE(PG8_SB(1, 1), b3 + hstep, voffB); PG8_STAGE(PG8_SA(1, 0), a3, voffA);
            PG8_WAIT_V(8); PG8_WAIT_L(0); PG8_BAR; PG8_MMA(1, 0, At, B0); PG8_MMA(1, 1, At, B1); PG8_BAR; PG8_SCHED;
            } else {
            PG8_LDB(B0, 0, 0); PG8_SCHED; PG8_LDA(At, 0, 0); PG8_STAGE(PG8_SA(1, 1), a1 + hstep, voffA);
            PG8_WAIT_L(8); PG8_BAR; PG8_WAIT_L(0); PG8_MMA(0, 0, At, B0); PG8_BAR; PG8_SCHED;
            PG8_LDB(B1, 0, 1); PG8_STAGE(PG8_SB(0, 0), b2, voffB);
            PG8_BAR; PG8_WAIT_L(0); PG8_MMA(0, 1, At, B1); PG8_BAR;
            PG8_LDA(At, 0, 1); PG8_STAGE(PG8_SA(0, 0), a2, voffA);
            PG8_BAR; PG8_WAIT_L(0); PG8_MMA(1, 0, At, B0); PG8_BAR; PG8_SCHED;
            PG8_STAGE(PG8_SB(0, 1), b2 + hstep, voffB);
            PG8_WAIT_V(6); PG8_BAR; PG8_MMA(1, 1, At, B1); PG8_BAR;
            PG8_LDB(B0, 1, 0); PG8_SCHED; PG8_LDA(At, 1, 0); PG8_STAGE(PG8_SA(0, 1), a2 + hstep, voffA);
            PG8_WAIT_L(8); PG8_BAR; PG8_WAIT_L(0); PG8_MMA(0, 0, At, B0); PG8_BAR; PG8_SCHED;
            PG8_LDB(B1, 1, 1); PG8_STAGE(PG8_SB(1, 0), b3, voffB);
            PG8_BAR; PG8_WAIT_L(0); PG8_MMA(0, 1, At, B1); PG8_BAR;
            PG8_LDA(At, 1, 1); PG8_STAGE(PG8_SA(1, 0), a3, voffA);
            PG8_BAR; PG8_WAIT_L(0); PG8_MMA(1, 0, At, B0); PG8_BAR; PG8_SCHED;
            PG8_STAGE(PG8_SB(1, 1), b3 + hstep, voffB);
            PG8_WAIT_V(6); PG8_BAR; PG8_MMA(1, 1, At, B1); PG8_BAR;
            }
        }
        if constexpr (ALIGN_EPI) { if (wr == 0) PG8_BAR; }
        if constexpr (!Epi::AFTER_DRAIN) { E(acc, cur, wr, wc, fr, fq); if (REP_PHASE == 40) E(acc, cur, wr, wc, fr, fq); S.done(cur); }
        if (!has_next) break;
#pragma unroll
        for (int a = 0; a < 2; ++a)
#pragma unroll
            for (int b = 0; b < 2; ++b)
#pragma unroll
                for (int m = 0; m < 4; ++m)
#pragma unroll
                    for (int n = 0; n < 2; ++n) acc[a][b][m][n] = (f32x4){0.f, 0.f, 0.f, 0.f};
        cur = nxt; cA = nA; cB = nB; ++ui;
        if constexpr (ALIGN_EPI) { if (wr == 1) PG8_BAR; }
    }
    PG8_WAIT_V(0);
    if constexpr (!ALIGN_EPI) { if (wr == 0) PG8_BAR; }
    PG8_BAR;
    if constexpr (Epi::AFTER_DRAIN) { E.fused(acc, cur, wr, wc, fr, fq, lds, wid, lane); S.done(cur); }
#undef PG8_SA
#undef PG8_SB
#undef PG8_STAGE
#undef PG8_LDA
#undef PG8_LDB
#undef PG8_MMA
#undef PG8_WAIT_V
#undef PG8_WAIT_L
#undef PG8_BAR
#undef PG8_SCHED
}
}
#define GAS __attribute__((address_space(1)))
#define LAS __attribute__((address_space(3)))
typedef unsigned short bf16;
typedef unsigned v4u __attribute__((ext_vector_type(4)));
typedef unsigned v2u __attribute__((ext_vector_type(2)));
typedef float f32x4 __attribute__((ext_vector_type(4)));
typedef float f32x2 __attribute__((ext_vector_type(2)));
typedef short bf16x8 __attribute__((ext_vector_type(8)));
typedef short s16x4 __attribute__((ext_vector_type(4)));
typedef float f32x16 __attribute__((ext_vector_type(16)));
typedef GAS unsigned gu32;
#define RLX_AGENT __ATOMIC_RELAXED, __HIP_MEMORY_SCOPE_AGENT
#define LDS_WAIT() asm volatile("s_waitcnt lgkmcnt(0)" ::: "memory")
#define VM_WAIT() asm volatile("s_waitcnt vmcnt(0)" ::: "memory")
constexpr int NWAVES = 8, NTHREADS = 512;
constexpr int LDS_BYTES = 160 * 1024;
constexpr int LDSCTL_OFF = LDS_BYTES - 512, MISC_OFF = LDSCTL_OFF + 256;
typedef __bf16 hwbf16x2_t __attribute__((ext_vector_type(2)));
__device__ __forceinline__ unsigned pk2(float lo, float hi) { f32x2 v = {lo, hi}; return __builtin_bit_cast(unsigned, __builtin_convertvector(v, hwbf16x2_t)); }
__device__ __forceinline__ unsigned f2bf(float f) { return (unsigned)__builtin_bit_cast(unsigned short, (__bf16)f); }
__device__ __forceinline__ float bf2f(unsigned short b) { return __builtin_bit_cast(float, (unsigned)b << 16); }
__device__ __forceinline__ float bflo(unsigned w) { return __builtin_bit_cast(float, w << 16); }
__device__ __forceinline__ float bfhi(unsigned w) { return __builtin_bit_cast(float, w & 0xffff0000u); }
__device__ __forceinline__ float sigmoidf_(float x) { return 1.0f / (1.0f + __expf(-x)); }
__device__ __forceinline__ float wave_sum(float v) {
#pragma unroll
    for (int o = 1; o < 64; o <<= 1) v += __shfl_xor(v, o);
    return v;
}
#define XB_TMO      128
#define XB_XCNT(j)  (256  + 64 * (j))
#define XB_XSUB(j)  (1280 + 64 * (j))
#define XB_XGEN(j)  (2304 + 64 * (j))
#define XB_TOP      3328
#define XB_TOPGEN   3392
#define XCD_BAR_WORDS 3456
#define XB_SPIN_CAP (1u << 18)

__device__ __forceinline__ unsigned xb_ld(unsigned* p)              { return __hip_atomic_load(p, __ATOMIC_RELAXED, __HIP_MEMORY_SCOPE_AGENT); }
__device__ __forceinline__ unsigned xb_add(unsigned* p, unsigned v) { return __hip_atomic_fetch_add(p, v, __ATOMIC_RELAXED, __HIP_MEMORY_SCOPE_AGENT); }
__device__ __forceinline__ unsigned xb_xcc_id() { return (unsigned)__builtin_amdgcn_s_getreg((3 << 11) | 20) & 0xFu; }
#define XB_SPIN(cond, bar) do { unsigned _sp = 0; while (cond) { __builtin_amdgcn_s_sleep(1); \
    if ((++_sp & 255u) == 0u) { if (xb_ld(&(bar)[XB_TMO])) break; if (_sp > XB_SPIN_CAP) { atomicAdd(&(bar)[XB_TMO], 1u); break; } } } } while (0)

struct XcdBarrier {
    unsigned* bar; unsigned x;
    volatile LAS unsigned* st;
};

__device__ __forceinline__ XcdBarrier xcd_barrier_post(unsigned* bar, volatile LAS unsigned* st) {
    XcdBarrier b; b.bar = bar; b.x = xb_xcc_id(); b.st = st;
    if (threadIdx.x == 0) (void)xb_add(&bar[XB_XCNT(b.x)], 1u);
    return b;
}
__device__ __forceinline__ void xcd_barrier_complete(unsigned* bar, unsigned x, unsigned& nloc, unsigned& nx) {
    const unsigned G = gridDim.x * gridDim.y * gridDim.z;
    unsigned sum, cnt, mine, sp = 0u;
    for (;;) {
        sum = 0u; cnt = 0u; mine = 0u;
#pragma unroll
        for (unsigned j = 0; j < 16; ++j) { const unsigned c = xb_ld(&bar[XB_XCNT(j)]); sum += c; cnt += (c > 0u) ? 1u : 0u; mine = (j == x) ? c : mine; }
        if (sum == G) break;
        __builtin_amdgcn_s_sleep(1);
        if ((++sp & 255u) == 0u) { if (xb_ld(&bar[XB_TMO])) break; if (sp > XB_SPIN_CAP) { atomicAdd(&bar[XB_TMO], 1u); break; } }
    }
    nloc = mine > 0u ? mine : 1u; nx = cnt > 0u ? cnt : 1u;
}

__device__ __forceinline__ void xcd_barrier(const XcdBarrier& b) {
    asm volatile("s_waitcnt vmcnt(0)" ::: "memory");
    __syncthreads();
    if (threadIdx.x == 0) {
        unsigned* bar = b.bar;
        __builtin_amdgcn_s_waitcnt(0);
        unsigned nloc = b.st[0], nx = b.st[1];
        if (nloc == 0u) { xcd_barrier_complete(bar, b.x, nloc, nx); b.st[0] = nloc; b.st[1] = nx; }
        const unsigned old = xb_add(&bar[XB_XSUB(b.x)], 1u);
        const unsigned gen = old / nloc;
        if (old + 1u == (gen + 1u) * nloc) {
            __builtin_amdgcn_fence(__ATOMIC_RELEASE, "agent");
            asm volatile("s_waitcnt vmcnt(0)" ::: "memory");
            const unsigned og = xb_add(&bar[XB_TOP], 1u);
            const unsigned tg = og / nx;
            if (og + 1u == (tg + 1u) * nx) xb_add(&bar[XB_TOPGEN], 1u);
            else XB_SPIN(xb_ld(&bar[XB_TOPGEN]) == tg, bar);
            __builtin_amdgcn_fence(__ATOMIC_ACQUIRE, "agent");
            xb_add(&bar[XB_XGEN(b.x)], 1u);
            asm volatile("s_waitcnt vmcnt(0)" ::: "memory");
        } else {
            XB_SPIN(xb_ld(&bar[XB_XGEN(b.x)]) == gen, bar);
            __builtin_amdgcn_fence(__ATOMIC_ACQUIRE, "agent");
            asm volatile("s_waitcnt vmcnt(0)" ::: "memory");
        }
    }
    __syncthreads();
}
namespace pg8 {
struct EpiInProj {
    static constexpr bool PERM = true, AFTER_DRAIN = false;
    bf16_t* PR; bf16_t* PD; bf16_t* PG; const float* qnw; const float* knw; const float* cs;
    __device__ __forceinline__ void operator()(const f32x4 (&acc)[2][2][4][2], const Unit& u, int wr, int wc, int fr, int fq) const {
        const int pn = u.pn; const int row0 = u.pm * BM + wr * 64 + fr;
        if (pn >= 13 && pn < 21) {
            const bool isq = pn < 17; const float* nw = isq ? qnw : knw; const float qs = isq ? 0.125f * 1.4426950408889634f : 1.0f;
            f32x4 wgt[2][2];
#pragma unroll
            for (int bj = 0; bj < 2; ++bj)
#pragma unroll
                for (int n = 0; n < 2; ++n) wgt[bj][n] = *(const f32x4*)(nw + 32 * bj + 8 * fq + 4 * n) * qs;
            const unsigned col = (unsigned)((pn - 13) * 256 + 64 * wc + 8 * fq);
#pragma unroll
            for (int ai = 0; ai < 2; ++ai)
#pragma unroll
                for (int m = 0; m < 4; ++m) { const int row = row0 + ai * HALF + m * 16;
                    const int pos = row < 16384 ? 16 + (row & 2047) : (row - 16384 < 16 ? row - 16384 : 0);
                    f32x4 v[2][2]; float ss = 0.f;
#pragma unroll
                    for (int bj = 0; bj < 2; ++bj)
#pragma unroll
                        for (int n = 0; n < 2; ++n) { v[bj][n] = acc[ai][bj][m][n]; ss += (v[bj][n][0] * v[bj][n][0] + v[bj][n][1] * v[bj][n][1]) + (v[bj][n][2] * v[bj][n][2] + v[bj][n][3] * v[bj][n][3]); }
                    ss += __shfl_xor(ss, 16); ss += __shfl_xor(ss, 32);
                    const float rstd = 1.0f / sqrtf(ss * (1.0f / 64.0f) + 1e-6f);
#pragma unroll
                    for (int bj = 0; bj < 2; ++bj)
#pragma unroll
                        for (int n = 0; n < 2; ++n) v[bj][n] = v[bj][n] * rstd * wgt[bj][n];
                    f32x4 o0, o1;
#pragma unroll
                    for (int e = 0; e < 4; ++e) { o0[e] = __shfl_xor(v[0][0][e], 16); o1[e] = __shfl_xor(v[0][1][e], 16); }
                    const float sgn = (fq == 0) ? -1.0f : 1.0f;
                    if (fq < 2) { const float* cp = cs + pos * 16; { const f32x4 c0 = *(const f32x4*)(cp), s0 = *(const f32x4*)(cp + 8); v[0][0] = v[0][0] * c0 + o0 * s0 * sgn; }
                        { const f32x4 c1 = *(const f32x4*)(cp + 4), s1 = *(const f32x4*)(cp + 12); v[0][1] = v[0][1] * c1 + o1 * s1 * sgn; } }
                    if (row < 16400) {
#pragma unroll
                        for (int bj = 0; bj < 2; ++bj) { u32x4 w; w.x = cvt_pk_bf16(v[bj][0][0], v[bj][0][1]); w.y = cvt_pk_bf16(v[bj][0][2], v[bj][0][3]); w.z = cvt_pk_bf16(v[bj][1][0], v[bj][1][1]); w.w = cvt_pk_bf16(v[bj][1][2], v[bj][1][3]);
                            *(u32x4*)(PD + (unsigned)row * 3072u + col + 32 * bj) = w; } } }
            return;
        }
        const bool t0 = pn < 13, t1 = pn < 25, sg = !t1;
        const long long d1 = (const char*)PD - (const char*)PG, d0 = (const char*)PR - (const char*)PD;
        bf16_t* base = (bf16_t*)((char*)PG + (t1 ? d1 : 0ll) + (t0 ? d0 : 0ll)); const unsigned ldc = t0 ? 3328u : (t1 ? 3072u : 2048u); const int colt = (t0 ? pn : (t1 ? pn - 13 : pn - 25)) * 256;
        const int rowlim = sg ? 16384 : 16400;
        const unsigned off0 = (unsigned)row0 * ldc + (unsigned)(colt + wc * 32 + 8 * fq);
#pragma unroll
        for (int ai = 0; ai < 2; ++ai)
#pragma unroll
            for (int m = 0; m < 4; ++m) { const int row = row0 + ai * HALF + m * 16; const unsigned off = off0 + (unsigned)(ai * HALF + m * 16) * ldc;
                if (row < rowlim) {
#pragma unroll
                for (int bj = 0; bj < 2; ++bj) { f32x4 v0 = acc[ai][bj][m][0], v1 = acc[ai][bj][m][1];
                    if (sg) {
#pragma unroll
                        for (int e = 0; e < 4; ++e) { v0[e] = __builtin_amdgcn_rcpf(1.0f + __expf(-v0[e])); v1[e] = __builtin_amdgcn_rcpf(1.0f + __expf(-v1[e])); } }
                    u32x4 w; w.x = cvt_pk_bf16(v0[0], v0[1]); w.y = cvt_pk_bf16(v0[2], v0[3]); w.z = cvt_pk_bf16(v1[0], v1[1]); w.w = cvt_pk_bf16(v1[2], v1[3]);
                    *(u32x4*)(base + off + bj * HALF) = w; } } }
    }
};
struct InProjOrder {
    StaticOrder so; int G, c;
    __device__ void init(int G_, int c_) { so.init(16384, 8448, G_, c_); G = G_; c = c_; }
    __device__ bool next(int i, Unit& u) const {
        if (so.next(i, u)) return true;
        const long L = (long)i * G + c - so.nwg; if (L < 0 || L >= 21) return false;
        u.pm = 64; u.pn = (L < 13) ? (int)L : (int)L + 4; return true;
    }
    __device__ __forceinline__ void a_ready(const Unit&) const {}
    __device__ __forceinline__ void done(const Unit&) const {}
};
}
namespace pg8 {
struct EpiGate {
    static constexpr bool PERM = true, AFTER_DRAIN = false;
    const bf16_t* PG; int goff; const bf16_t* T1; bf16_t* O;
    __device__ __forceinline__ void operator()(const f32x4 (&acc)[2][2][4][2], const Unit& u, int wr, int wc, int fr, int fq) const {
        const int row0 = u.pm * BM + wr * 64 + fr, col0 = u.pn * BM + wc * 32 + 8 * fq;
#pragma unroll
        for (int ai = 0; ai < 2; ++ai) {
            u32x4 gw[4][2], tw[4][2];
#pragma unroll
            for (int m = 0; m < 4; ++m)
#pragma unroll
                for (int bj = 0; bj < 2; ++bj) { const size_t row = row0 + ai * HALF + m * 16; const int col = col0 + bj * HALF;
                    gw[m][bj] = *(const u32x4*)(PG + row * 2048 + goff + col);
                    if (T1) tw[m][bj] = *(const u32x4*)(T1 + row * 1024 + col); else tw[m][bj] = (u32x4){0u, 0u, 0u, 0u}; }
#pragma unroll
            for (int m = 0; m < 4; ++m)
#pragma unroll
                for (int bj = 0; bj < 2; ++bj) { const size_t row = row0 + ai * HALF + m * 16; const int col = col0 + bj * HALF;
                    const u32x4 g = gw[m][bj], t = tw[m][bj]; f32x4 v0 = acc[ai][bj][m][0], v1 = acc[ai][bj][m][1];
                    v0[0] = v0[0] * __builtin_bit_cast(float, g.x << 16) + __builtin_bit_cast(float, t.x << 16); v0[1] = v0[1] * __builtin_bit_cast(float, g.x & 0xffff0000u) + __builtin_bit_cast(float, t.x & 0xffff0000u);
                    v0[2] = v0[2] * __builtin_bit_cast(float, g.y << 16) + __builtin_bit_cast(float, t.y << 16); v0[3] = v0[3] * __builtin_bit_cast(float, g.y & 0xffff0000u) + __builtin_bit_cast(float, t.y & 0xffff0000u);
                    v1[0] = v1[0] * __builtin_bit_cast(float, g.z << 16) + __builtin_bit_cast(float, t.z << 16); v1[1] = v1[1] * __builtin_bit_cast(float, g.z & 0xffff0000u) + __builtin_bit_cast(float, t.z & 0xffff0000u);
                    v1[2] = v1[2] * __builtin_bit_cast(float, g.w << 16) + __builtin_bit_cast(float, t.w << 16); v1[3] = v1[3] * __builtin_bit_cast(float, g.w & 0xffff0000u) + __builtin_bit_cast(float, t.w & 0xffff0000u);
                    u32x4 w; w.x = cvt_pk_bf16(v0[0], v0[1]); w.y = cvt_pk_bf16(v0[2], v0[3]); w.z = cvt_pk_bf16(v1[0], v1[1]); w.w = cvt_pk_bf16(v1[2], v1[3]);
                    *(u32x4*)(O + row * 1024 + col) = w; }
            asm volatile("" ::: "memory");
        }
    }
};
struct BranchOrder {
    StaticOrder so;
    __device__ bool next(int i, Unit& u) const { if (!so.next(i >> 1, u)) return false; if (i & 1) { u.pm += 64; u.pn += 4; } return true; }
    __device__ __forceinline__ void a_ready(const Unit&) const {}
    __device__ __forceinline__ void done(const Unit&) const {}
};
struct EpiBranch {
    static constexpr bool PERM = true, AFTER_DRAIN = false;
    const bf16_t* PG; bf16_t* T1; bf16_t* O;
    __device__ __forceinline__ void operator()(const f32x4 (&acc)[2][2][4][2], const Unit& u, int wr, int wc, int fr, int fq) const {
        const bool seg1 = u.pn >= 4;
        const int row0 = (u.pm & 63) * BM + wr * 64 + fr, col0 = (u.pn & 3) * BM + wc * 32 + 8 * fq; const int goff = seg1 ? 1024 : 0;
        bf16_t* dst = seg1 ? O : T1;
#pragma unroll
        for (int ai = 0; ai < 2; ++ai) {
            u32x4 gw[4][2], tw[4][2];
#pragma unroll
            for (int m = 0; m < 4; ++m)
#pragma unroll
                for (int bj = 0; bj < 2; ++bj) { const size_t row = row0 + ai * HALF + m * 16; const int col = col0 + bj * HALF;
                    gw[m][bj] = *(const u32x4*)(PG + row * 2048 + goff + col);
                    tw[m][bj] = seg1 ? *(const u32x4*)(T1 + row * 1024 + col) : (u32x4){0u, 0u, 0u, 0u}; }
#pragma unroll
            for (int m = 0; m < 4; ++m)
#pragma unroll
                for (int bj = 0; bj < 2; ++bj) { const size_t row = row0 + ai * HALF + m * 16; const int col = col0 + bj * HALF;
                    const u32x4 g = gw[m][bj]; const u32x4 t = tw[m][bj];
                    f32x4 v0 = acc[ai][bj][m][0], v1 = acc[ai][bj][m][1];
                    v0[0] = v0[0] * __builtin_bit_cast(float, g.x << 16) + __builtin_bit_cast(float, t.x << 16); v0[1] = v0[1] * __builtin_bit_cast(float, g.x & 0xffff0000u) + __builtin_bit_cast(float, t.x & 0xffff0000u);
                    v0[2] = v0[2] * __builtin_bit_cast(float, g.y << 16) + __builtin_bit_cast(float, t.y << 16); v0[3] = v0[3] * __builtin_bit_cast(float, g.y & 0xffff0000u) + __builtin_bit_cast(float, t.y & 0xffff0000u);
                    v1[0] = v1[0] * __builtin_bit_cast(float, g.z << 16) + __builtin_bit_cast(float, t.z << 16); v1[1] = v1[1] * __builtin_bit_cast(float, g.z & 0xffff0000u) + __builtin_bit_cast(float, t.z & 0xffff0000u);
                    v1[2] = v1[2] * __builtin_bit_cast(float, g.w << 16) + __builtin_bit_cast(float, t.w << 16); v1[3] = v1[3] * __builtin_bit_cast(float, g.w & 0xffff0000u) + __builtin_bit_cast(float, t.w & 0xffff0000u);
                    u32x4 w; w.x = cvt_pk_bf16(v0[0], v0[1]); w.y = cvt_pk_bf16(v0[2], v0[3]); w.z = cvt_pk_bf16(v1[0], v1[1]); w.w = cvt_pk_bf16(v1[2], v1[3]);
                    *(u32x4*)(dst + row * 1024 + col) = w; }
            asm volatile("" ::: "memory");
        }
    }
};
struct EpiResF32 {
    static constexpr bool PERM = false, AFTER_DRAIN = false;
    const float* res; float* O;
    __device__ __forceinline__ void operator()(const f32x4 (&acc)[2][2][4][2], const Unit& u, int wr, int wc, int fr, int fq) const {
        const int row0 = u.pm * BM + wr * 64 + fr, col0 = u.pn * BM + wc * 32 + 4 * fq;
#pragma unroll
        for (int ai = 0; ai < 2; ++ai) {
            f32x4 r[4][2][2];
#pragma unroll
            for (int m = 0; m < 4; ++m)
#pragma unroll
                for (int bj = 0; bj < 2; ++bj)
#pragma unroll
                    for (int n = 0; n < 2; ++n) r[m][bj][n] = *(const f32x4*)(res + (size_t)(row0 + ai * HALF + m * 16) * 1024 + col0 + bj * HALF + n * 16);
#pragma unroll
            for (int m = 0; m < 4; ++m)
#pragma unroll
                for (int bj = 0; bj < 2; ++bj)
#pragma unroll
                    for (int n = 0; n < 2; ++n) *(f32x4*)(O + (size_t)(row0 + ai * HALF + m * 16) * 1024 + col0 + bj * HALF + n * 16) = r[m][bj][n] + acc[ai][bj][m][n];
            asm volatile("" ::: "memory");
        }
    }
};
}
namespace pg8 {
struct Seg2 { int nt1; size_t dA, dB; };
template <class Epi, class Sched, int NT1 = 0, size_t DA = 0, size_t DB = 0>
__device__ __forceinline__ void gemm_phase_g(PG8_LAS unsigned char* lds, const Gemm g, const Sched& S, const Epi& E) {
    constexpr bool SEG2 = NT1 > 0; constexpr Seg2 sg{NT1, DA, DB};
    int tid_ = threadIdx.x; asm volatile("" : "+v"(tid_)); const int tid = tid_, wid = __builtin_amdgcn_readfirstlane(tid >> 6), lane = tid & 63, wr = wid >> 2, wc = wid & 3, fr = lane & 15, fq = lane >> 4;
    const int K = g.K, nt = K / BK;
    int RA[2], CA2[2]; unsigned voffB[2];
#pragma unroll
    for (int i = 0; i < 2; ++i) { int R, C; stage_rc(tid * 16 + i * 8192, R, C); const int Rb = Epi::PERM ? ((R & ~31) + perm32(R & 31)) : R; RA[i] = R; CA2[i] = C * 2; voffB[i] = (unsigned)(Rb * K + C) * 2u; }
    const size_t kstep = (size_t)(BK * 2);
#define PG8_KA(tt) (SEG2 && (tt) >= sg.nt1 ? sg.dA + (size_t)((tt) - sg.nt1) * kstep : (size_t)(tt) * kstep)
#define PG8_KB(tt) (SEG2 && (tt) >= sg.nt1 ? sg.dB + (size_t)((tt) - sg.nt1) * kstep : (size_t)(tt) * kstep)
    const size_t hstep = (size_t)HALF * K * 2;
    const size_t tstep = 2 * hstep;
    const unsigned ldsw = (unsigned)wid * 1024u;
    const int aoff = lds_byte(wr * 64 + fr, fq * 8), boff = lds_byte(wc * 32 + fr, fq * 8);
#define PG8_SA(b, h) (((b) * 2 + (h)) * HTB)
#define PG8_SB(b, h) ((4 + (b) * 2 + (h)) * HTB)
#define PG8_STAGE(bufoff, gbase, voff) do { _Pragma("unroll") for (int _i = 0; _i < 2; ++_i) \
        __builtin_amdgcn_global_load_lds((const unsigned*)((const char*)(gbase) + (voff)[_i]), (PG8_LAS unsigned*)(lds + (bufoff) + ldsw + _i * 8192), 16, 0, 0); } while (0)
#define PG8_STAGEA(bufoff, O, h, kb) do { _Pragma("unroll") for (int _i = 0; _i < 2; ++_i) \
        __builtin_amdgcn_global_load_lds((const unsigned*)((const char*)g.A + (size_t)(O)[h][_i] + (kb)), (PG8_LAS unsigned*)(lds + (bufoff) + ldsw + _i * 8192), 16, 0, 0); } while (0)
#define PG8_LDA(dst, b, h) do { _Pragma("unroll") for (int m = 0; m < 4; ++m) _Pragma("unroll") for (int k = 0; k < 2; ++k) dst[m][k] = *(const PG8_LAS bf16x8*)(lds + PG8_SA(b, h) + aoff + m * 2048 + k * 1024); } while (0)
#define PG8_LDB(dst, b, h) do { _Pragma("unroll") for (int n = 0; n < 2; ++n) _Pragma("unroll") for (int k = 0; k < 2; ++k) dst[n][k] = *(const PG8_LAS bf16x8*)(lds + PG8_SB(b, h) + boff + n * 2048 + k * 1024); } while (0)
#define PG8_MMA(ai, bj, At, Bt) do { __builtin_amdgcn_s_setprio(1); _Pragma("unroll") for (int m = 0; m < 4; ++m) _Pragma("unroll") for (int n = 0; n < 2; ++n) _Pragma("unroll") for (int k = 0; k < 2; ++k) \
        acc[ai][bj][m][n] = __builtin_amdgcn_mfma_f32_16x16x32_bf16(Bt[n][k], At[m][k], acc[ai][bj][m][n], 0, 0, 0); __builtin_amdgcn_s_setprio(0); } while (0)
#define PG8_WAIT_V(n) asm volatile("s_waitcnt vmcnt(" #n ")" ::: "memory")
#define PG8_WAIT_L(n) asm volatile("s_waitcnt lgkmcnt(" #n ")" ::: "memory")
#define PG8_BAR __builtin_amdgcn_s_barrier()
#define PG8_SCHED __builtin_amdgcn_sched_barrier(0)
#define PG8_AOFF(O, u) do { _Pragma("unroll") for (int _h = 0; _h < 2; ++_h) _Pragma("unroll") for (int _i = 0; _i < 2; ++_i) (O)[_h][_i] = S.a_row_off((u), _h * HALF + RA[_i]) + (unsigned)CA2[_i]; } while (0)
    Unit cur, nxt; int ui = 0;
    if (!S.next(0, cur)) return;
    f32x4 acc[2][2][4][2];
#pragma unroll
    for (int a = 0; a < 2; ++a)
#pragma unroll
        for (int b = 0; b < 2; ++b)
#pragma unroll
            for (int m = 0; m < 4; ++m)
#pragma unroll
                for (int n = 0; n < 2; ++n) acc[a][b][m][n] = (f32x4){0.f, 0.f, 0.f, 0.f};
    bf16x8 At[4][2], B0[2][2], B1[2][2];
    unsigned cO[2][2], nO[2][2];
    PG8_AOFF(cO, cur);
    const char* cB = (const char*)g.Bt + (size_t)cur.pn * tstep;
    PG8_STAGE(PG8_SB(0, 0), cB, voffB); PG8_STAGE(PG8_SB(0, 1), cB + hstep, voffB); PG8_STAGEA(PG8_SA(0, 0), cO, 0, 0); PG8_STAGEA(PG8_SA(0, 1), cO, 1, 0);
    if (wr == 1) PG8_BAR;
    PG8_WAIT_V(2); PG8_BAR;
    PG8_STAGE(PG8_SB(1, 0), cB + kstep, voffB); PG8_STAGEA(PG8_SA(1, 0), cO, 0, kstep); PG8_STAGE(PG8_SB(1, 1), cB + hstep + kstep, voffB);
    PG8_WAIT_V(6); PG8_BAR;
    for (;;) {
        const bool has_next = S.next(ui + 1, nxt);
        if constexpr (Sched::GATHER) { if (has_next) { PG8_AOFF(nO, nxt); } else {
#pragma unroll
            for (int _h = 0; _h < 2; ++_h)
#pragma unroll
                for (int _i = 0; _i < 2; ++_i) nO[_h][_i] = cO[_h][_i]; } }
        const char* nB = has_next ? (const char*)g.Bt + (size_t)nxt.pn * tstep : cB;
        for (int t = 0; t < nt; t += 2) {
            const bool last = (t == nt - 2);
            if constexpr (SEG2) { if (t == sg.nt1) { PG8_SCHED; E.mid(acc, cur, wr, wc, fr, fq); PG8_SCHED; } }
            const size_t k1 = PG8_KA(t + 1), k2 = last ? 0 : PG8_KA(t + 2), k3 = last ? kstep : PG8_KA(t + 3);
            unsigned o2[2][2];
            if constexpr (Sched::GATHER) {
#pragma unroll
                for (int _h = 0; _h < 2; ++_h)
#pragma unroll
                    for (int _i = 0; _i < 2; ++_i) o2[_h][_i] = last ? nO[_h][_i] : cO[_h][_i];
            } else { const Unit uu = (last && has_next) ? nxt : cur; PG8_AOFF(o2, uu); }
            const char* b2 = last ? nB : cB + PG8_KB(t + 2); const char* b3 = last ? nB + kstep : cB + PG8_KB(t + 3);
            PG8_LDB(B0, 0, 0); PG8_LDB(B1, 0, 1); PG8_SCHED; PG8_LDA(At, 0, 0); PG8_STAGEA(PG8_SA(1, 1), cO, 1, k1);
            PG8_WAIT_V(8); PG8_WAIT_L(0); PG8_BAR; PG8_MMA(0, 0, At, B0); PG8_MMA(0, 1, At, B1); PG8_BAR; PG8_SCHED;
            PG8_LDA(At, 0, 1); PG8_STAGE(PG8_SB(0, 0), b2, voffB); PG8_STAGE(PG8_SB(0, 1), b2 + hstep, voffB); PG8_STAGEA(PG8_SA(0, 0), o2, 0, k2);
            PG8_WAIT_V(8); PG8_WAIT_L(0); PG8_BAR; PG8_MMA(1, 0, At, B0); PG8_MMA(1, 1, At, B1); PG8_BAR; PG8_SCHED;
            PG8_LDB(B0, 1, 0); PG8_LDB(B1, 1, 1); PG8_SCHED; PG8_LDA(At, 1, 0); PG8_STAGEA(PG8_SA(0, 1), o2, 1, k2);
            PG8_WAIT_V(8); PG8_WAIT_L(0); PG8_BAR; PG8_MMA(0, 0, At, B0); PG8_MMA(0, 1, At, B1); PG8_BAR; PG8_SCHED;
            PG8_LDA(At, 1, 1); PG8_STAGE(PG8_SB(1, 0), b3, voffB); PG8_STAGE(PG8_SB(1, 1), b3 + hstep, voffB); PG8_STAGEA(PG8_SA(1, 0), o2, 0, k3);
            PG8_WAIT_V(8); PG8_WAIT_L(0); PG8_BAR; PG8_MMA(1, 0, At, B0); PG8_MMA(1, 1, At, B1); PG8_BAR; PG8_SCHED;
        }
        if (wr == 0) PG8_BAR;
        E(acc, cur, wr, wc, fr, fq);
        if (!has_next) break;
#pragma unroll
        for (int a = 0; a < 2; ++a)
#pragma unroll
            for (int b = 0; b < 2; ++b)
#pragma unroll
                for (int m = 0; m < 4; ++m)
#pragma unroll
                    for (int n = 0; n < 2; ++n) acc[a][b][m][n] = (f32x4){0.f, 0.f, 0.f, 0.f};
        cur = nxt; cB = nB; ++ui;
        if constexpr (Sched::GATHER) {
#pragma unroll
            for (int _h = 0; _h < 2; ++_h)
#pragma unroll
                for (int _i = 0; _i < 2; ++_i) cO[_h][_i] = nO[_h][_i];
        } else { PG8_AOFF(cO, cur); }
        if (wr == 1) PG8_BAR;
    }
    PG8_WAIT_V(0);
    PG8_BAR;
#undef PG8_SA
#undef PG8_SB
#undef PG8_STAGE
#undef PG8_STAGEA
#undef PG8_LDA
#undef PG8_LDB
#undef PG8_MMA
#undef PG8_WAIT_V
#undef PG8_WAIT_L
#undef PG8_BAR
#undef PG8_SCHED
#undef PG8_AOFF
#undef PG8_KA
#undef PG8_KB
}
}
__device__ __forceinline__ void transpose_item(const float* W, int N, bf16* WT, int ldt, int drow, int k0, int n0, LAS float* scr, int lane) {
    f32x4 v[8];
#pragma unroll
    for (int i = 0; i < 8; ++i) v[i] = *(const GAS f32x4*)(W + (size_t)(k0 + 8 * i + (lane >> 3)) * N + n0 + 4 * (lane & 7));
#pragma unroll
    for (int i = 0; i < 8; ++i) { LAS float* d = scr + (8 * i + (lane >> 3)) * 33 + 4 * (lane & 7); d[0] = v[i].x; d[1] = v[i].y; d[2] = v[i].z; d[3] = v[i].w; }
    LDS_WAIT(); asm volatile("" ::: "memory");
    const int c = lane & 7;
#pragma unroll
    for (int j = 0; j < 4; ++j) { const int n = (lane >> 3) + 8 * j; const LAS float* s = scr + (8 * c) * 33 + n;
        v4u o; o.x = pk2(s[0 * 33], s[1 * 33]); o.y = pk2(s[2 * 33], s[3 * 33]); o.z = pk2(s[4 * 33], s[5 * 33]); o.w = pk2(s[6 * 33], s[7 * 33]);
        *(GAS v4u*)(WT + (size_t)(drow + n) * ldt + k0 + 8 * c) = o; }
    LDS_WAIT(); asm volatile("" ::: "memory");
}
struct TrLoad { f32x4 v[8]; };
__device__ __forceinline__ void transpose_issue(TrLoad& t, const float* W, int N, int k0, int n0, int lane) {
#pragma unroll
    for (int i = 0; i < 8; ++i) t.v[i] = *(const GAS f32x4*)(W + (size_t)(k0 + 8 * i + (lane >> 3)) * N + n0 + 4 * (lane & 7));
}
__device__ __forceinline__ void transpose_finish(const TrLoad& t, bf16* WT, int ldt, int drow, int k0, LAS float* scr, int lane) {
#pragma unroll
    for (int i = 0; i < 8; ++i) { LAS float* d = scr + (8 * i + (lane >> 3)) * 33 + 4 * (lane & 7); d[0] = t.v[i].x; d[1] = t.v[i].y; d[2] = t.v[i].z; d[3] = t.v[i].w; }
    LDS_WAIT(); asm volatile("" ::: "memory");
    const int c = lane & 7;
#pragma unroll
    for (int j = 0; j < 4; ++j) { const int n = (lane >> 3) + 8 * j; const LAS float* s = scr + (8 * c) * 33 + n;
        v4u o; o.x = pk2(s[0 * 33], s[1 * 33]); o.y = pk2(s[2 * 33], s[3 * 33]); o.z = pk2(s[4 * 33], s[5 * 33]); o.w = pk2(s[6 * 33], s[7 * 33]);
        *(GAS v4u*)(WT + (size_t)(drow + n) * ldt + k0 + 8 * c) = o; }
    LDS_WAIT(); asm volatile("" ::: "memory");
}
__device__ __forceinline__ void rms_row_to_bf16(const float* xrow, const float* w, bf16* orow, int lane) {
    const GAS f32x4* xr = (const GAS f32x4*)xrow + lane; const GAS f32x4* wr = (const GAS f32x4*)w + lane;
    f32x4 v[4]; float s2 = 0.f;
#pragma unroll
    for (int j = 0; j < 4; ++j) { v[j] = xr[64 * j]; s2 += (v[j].x * v[j].x + v[j].y * v[j].y) + (v[j].z * v[j].z + v[j].w * v[j].w); }
    const float rstd = 1.f / sqrtf(wave_sum(s2) * (1.f / D) + NORM_EPS);
    GAS unsigned long long* o8 = (GAS unsigned long long*)orow + lane;
#pragma unroll
    for (int j = 0; j < 4; ++j) { const f32x4 g = wr[64 * j];
        o8[64 * j] = (unsigned long long)pk2(v[j].x * rstd * g.x, v[j].y * rstd * g.y) | ((unsigned long long)pk2(v[j].z * rstd * g.z, v[j].w * rstd * g.w) << 32); }
}

__device__ __forceinline__ void rms_row2_to_bf16(const float* xa, const float* xb, const float* w, bf16* oa, bf16* ob, int lane) {
    const GAS f32x4* xra = (const GAS f32x4*)xa + lane; const GAS f32x4* xrb = (const GAS f32x4*)xb + lane; const GAS f32x4* wr = (const GAS f32x4*)w + lane;
    f32x4 va[4], vb[4], g[4]; float sa = 0.f, sb = 0.f;
#pragma unroll
    for (int j = 0; j < 4; ++j) { va[j] = xra[64 * j]; vb[j] = xrb[64 * j]; g[j] = wr[64 * j]; }
#pragma unroll
    for (int j = 0; j < 4; ++j) { sa += (va[j].x * va[j].x + va[j].y * va[j].y) + (va[j].z * va[j].z + va[j].w * va[j].w); sb += (vb[j].x * vb[j].x + vb[j].y * vb[j].y) + (vb[j].z * vb[j].z + vb[j].w * vb[j].w); }
    const float ra = 1.f / sqrtf(wave_sum(sa) * (1.f / D) + NORM_EPS), rb = 1.f / sqrtf(wave_sum(sb) * (1.f / D) + NORM_EPS);
    GAS unsigned long long* pa = (GAS unsigned long long*)oa + lane; GAS unsigned long long* pb = (GAS unsigned long long*)ob + lane;
#pragma unroll
    for (int j = 0; j < 4; ++j) { const f32x4 a = va[j] * ra * g[j], b = vb[j] * rb * g[j];
        pa[64 * j] = (unsigned long long)pk2(a.x, a.y) | ((unsigned long long)pk2(a.z, a.w) << 32); pb[64 * j] = (unsigned long long)pk2(b.x, b.y) | ((unsigned long long)pk2(b.z, b.w) << 32); }
}
constexpr float ATT_C2 = 0.125f * 1.4426950408889634f;
__device__ __forceinline__ void qk_prepass_row(bf16* prow, int pos, bool do_q, const float* qnw, const float* knw, int lane) {
#pragma unroll
    for (int ps = 0; ps < 4; ++ps) {
        const bool isq = ps < 2;
        if (isq && !do_q) continue;
        const int col = ps * 512 + lane * 8, dl = (lane & 7) * 8;
        v4u raw = *(const GAS v4u*)(prow + col);
        float v[8]; v[0] = bflo(raw.x); v[1] = bfhi(raw.x); v[2] = bflo(raw.y); v[3] = bfhi(raw.y); v[4] = bflo(raw.z); v[5] = bfhi(raw.z); v[6] = bflo(raw.w); v[7] = bfhi(raw.w);
        float ss = 0.f;
#pragma unroll
        for (int j = 0; j < 8; ++j) ss += v[j] * v[j];
        ss += __shfl_xor(ss, 1); ss += __shfl_xor(ss, 2); ss += __shfl_xor(ss, 4);
        const float rstd = 1.f / sqrtf(ss * (1.f / 64.f) + NORM_EPS);
        const float* nw = isq ? qnw : knw;
#pragma unroll
        for (int j = 0; j < 8; ++j) v[j] = v[j] * rstd * nw[dl + j];
        float oth[8];
#pragma unroll
        for (int j = 0; j < 8; ++j) oth[j] = __shfl_xor(v[j], 1);
        if (dl < 16) {
#pragma unroll
            for (int j = 0; j < 8; ++j) {
                const float invf = expf(-13.122363377404328f * (float)j * 2.0f / 16.0f);
                float sn, cs; sincosf((float)pos * invf, &sn, &cs);
                v[j] = (dl == 0) ? (v[j] * cs - oth[j] * sn) : (v[j] * cs + oth[j] * sn);
            }
        }
        if (isq) {
#pragma unroll
            for (int j = 0; j < 8; ++j) v[j] *= ATT_C2;
        }
        v4u o; o.x = pk2(v[0], v[1]); o.y = pk2(v[2], v[3]); o.z = pk2(v[4], v[5]); o.w = pk2(v[6], v[7]);
        *(GAS v4u*)(prow + col) = o;
    }
}

namespace att {
constexpr int SLOTB = 32768, L_K0 = 0, L_K1 = 8192, L_V = 16384, L_WS = 65536, L_X = 67584, L_END = L_X + 65536;
static_assert(L_END <= LDSCTL_OFF, "attention LDS");
__device__ __forceinline__ int crow(int r, int hi) { return (r & 3) + 8 * (r >> 2) + 4 * hi; }
__device__ __forceinline__ int key_row(int b, int pos) { int s = pos - NMETA; s = s > SEQ - 1 ? SEQ - 1 : s; return pos < NMETA ? MX + pos : b * SEQ + s; }
__device__ __forceinline__ s16x4 vtr(LAS const unsigned char* p) { typedef short v4i16_t __attribute__((ext_vector_type(4)));
    return __builtin_bit_cast(s16x4, __builtin_amdgcn_ds_read_tr16_b64_v4i16((LAS v4i16_t*)p)); }
__device__ __forceinline__ unsigned cvtpk(float lo, float hi) { typedef __bf16 bf16x2_t __attribute__((ext_vector_type(2))); f32x2 v = {lo, hi}; bf16x2_t b = __builtin_convertvector(v, bf16x2_t); return __builtin_bit_cast(unsigned, b); }

__device__ __forceinline__ void unit(LAS unsigned char* lds, const bf16* PD, bf16* DO, int b, int h, int qb, float lam, const float* subw) {
    int tid_ = threadIdx.x; asm volatile("" : "+v"(tid_)); const int tid = tid_, lane = tid & 63, r32 = lane & 31, hi = lane >> 5; const int wid = __builtin_amdgcn_readfirstlane(tid >> 6);
    const int c = wid >> 2, wq = wid & 3;
    const int NT = 2 * qb + 3;
    const int qpos = NMETA + 128 * qb + 32 * wq + r32;
    bf16x8 qr[4];
    { const bf16* qp = PD + (size_t)(b * SEQ + 128 * qb + 32 * wq + r32) * DF_COLS + h * 128 + c * 64 + hi * 8;
#pragma unroll
      for (int d0 = 0; d0 < 4; ++d0) qr[d0] = *(const GAS bf16x8*)(qp + d0 * 16); }
    const int kp = wid, vp0i = wid, vp1i = wid + 8;
    v4u sk0, sk1, sv0, sv1;
    const bf16* kbase = PD + 1024 + h * 128 + kp * 8;
    const bf16* vbase0 = PD + 2048 + h * 128 + 32 * (vp0i >> 2) + (lane & 3) * 8;
    const bf16* vbase1 = PD + 2048 + h * 128 + 32 * (vp1i >> 2) + (lane & 3) * 8;
    const int kl = lane, vl0 = 16 * (vp0i & 3) + (lane >> 2), vl1 = 16 * (vp1i & 3) + (lane >> 2);
#define ATT_ROW(p) ((p) < NMETA ? MX + (p) : b * SEQ + ((p) - NMETA > SEQ - 1 ? SEQ - 1 : (p) - NMETA))
#define ATT_LOAD(t) do { const int pk = 64 * (t) + kl, pa = 64 * (t) + vl0, pb = 64 * (t) + vl1; const bf16* kr = kbase + (size_t)ATT_ROW(pk) * DF_COLS; \
        sk0 = *(const GAS v4u*)(kr); sk1 = *(const GAS v4u*)(kr + 64); \
        sv0 = *(const GAS v4u*)(vbase0 + (size_t)ATT_ROW(pa) * DF_COLS); sv1 = *(const GAS v4u*)(vbase1 + (size_t)ATT_ROW(pb) * DF_COLS); } while (0)
#define ATT_WRITE(slot) do { LAS unsigned char* sb_ = lds + (slot) * SLOTB; \
        *(LAS v4u*)(sb_ + L_K0 + kp * 1024 + lane * 16) = sk0; *(LAS v4u*)(sb_ + L_K1 + kp * 1024 + lane * 16) = sk1; \
        *(LAS v4u*)(sb_ + L_V + vp0i * 1024 + lane * 16) = sv0; *(LAS v4u*)(sb_ + L_V + vp1i * 1024 + lane * 16) = sv1; } while (0)
    LAS float* wsf = (LAS float*)(lds + L_WS) + wid * 64;
    f32x16 o[4];
#pragma unroll
    for (int i = 0; i < 4; ++i) o[i] = f32x16{};
    f32x16 negm = f32x16{};
    float mref = 0.f, lrun = 0.f;
    constexpr float THR = 6.0f;
    ATT_LOAD(0); ATT_WRITE(0);
    __syncthreads();
    for (int t = 0; t < NT; ++t) {
        if (t + 1 < NT) ATT_LOAD(t + 1);
        LAS const unsigned char* sb = lds + (t & 1) * SLOTB;
        f32x16 p0 = negm, p1 = negm;
        { LAS const unsigned char* kb = sb + (c ? L_K1 : L_K0) + hi * 1024 + r32 * 16;
#pragma unroll
          for (int d0 = 0; d0 < 4; ++d0) {
              const bf16x8 b0 = *(LAS const bf16x8*)(kb + d0 * 2048); const bf16x8 b1 = *(LAS const bf16x8*)(kb + d0 * 2048 + 512);
              p0 = __builtin_amdgcn_mfma_f32_32x32x16_bf16(b0, qr[d0], p0, 0, 0, 0); p1 = __builtin_amdgcn_mfma_f32_32x32x16_bf16(b1, qr[d0], p1, 0, 0, 0); } }
        if (64 * t + 63 > NMETA + 128 * qb + 32 * wq) {
#pragma unroll
            for (int r = 0; r < 16; ++r) { const int kv = 64 * t + crow(r, hi); if (kv > qpos) p0[r] = -INFINITY; if (kv + 32 > qpos) p1[r] = -INFINITY; }
        }
        float rm = fmaxf(p0[0], p1[0]);
#pragma unroll
        for (int r = 1; r < 16; ++r) rm = fmaxf(rm, fmaxf(p0[r], p1[r]));
        rm = fmaxf(rm, __shfl_xor(rm, 32));
        if (__any((t == 0) || (rm > THR))) {
            const float dl = (t == 0) ? rm : fmaxf(rm, 0.f);
            mref += dl;
#pragma unroll
            for (int r = 0; r < 16; ++r) { p0[r] -= dl; p1[r] -= dl; negm[r] = -mref; }
            const float f = __builtin_amdgcn_exp2f(-dl); lrun *= f;
            if (t > 0) {
                if (hi == 0) wsf[r32] = f;
                asm volatile("s_waitcnt lgkmcnt(0)" ::: "memory");
#pragma unroll
                for (int r = 0; r < 16; ++r) { const float fr_ = wsf[crow(r, hi)];
#pragma unroll
                    for (int d0 = 0; d0 < 4; ++d0) o[d0][r] *= fr_; }
            }
        }
        float sacc = 0.f;
#pragma unroll
        for (int r = 0; r < 16; ++r) { p0[r] = __builtin_amdgcn_exp2f(p0[r]); p1[r] = __builtin_amdgcn_exp2f(p1[r]); sacc += p0[r] + p1[r]; }
        lrun += sacc;
        v4u pw[4];
        pw[0] = (v4u){cvtpk(p0[0], p0[1]), cvtpk(p0[2], p0[3]), cvtpk(p0[4], p0[5]), cvtpk(p0[6], p0[7])};
        pw[1] = (v4u){cvtpk(p0[8], p0[9]), cvtpk(p0[10], p0[11]), cvtpk(p0[12], p0[13]), cvtpk(p0[14], p0[15])};
        pw[2] = (v4u){cvtpk(p1[0], p1[1]), cvtpk(p1[2], p1[3]), cvtpk(p1[4], p1[5]), cvtpk(p1[6], p1[7])};
        pw[3] = (v4u){cvtpk(p1[8], p1[9]), cvtpk(p1[10], p1[11]), cvtpk(p1[12], p1[13]), cvtpk(p1[14], p1[15])};
        { LAS const unsigned char* vb = sb + L_V + ((lane >> 4) & 1) * 32 + (lane & 3) * 8 + (4 * hi + ((lane & 15) >> 2)) * 64;
#pragma unroll
          for (int d0 = 0; d0 < 4; ++d0)
#pragma unroll
              for (int ks = 0; ks < 4; ++ks) {
                  const s16x4 lo = vtr(vb + d0 * 4096 + ks * 1024), hh = vtr(vb + d0 * 4096 + ks * 1024 + 512);
                  const bf16x8 vf = (bf16x8){lo[0], lo[1], lo[2], lo[3], hh[0], hh[1], hh[2], hh[3]};
                  o[d0] = __builtin_amdgcn_mfma_f32_32x32x16_bf16(__builtin_bit_cast(bf16x8, pw[ks]), vf, o[d0], 0, 0, 0); } }
        if (t + 1 < NT) ATT_WRITE((t + 1) & 1);
        __syncthreads();
    }
#undef ATT_LOAD
#undef ATT_WRITE
#undef ATT_ROW
    lrun += __shfl_xor(lrun, 32);
    if (hi == 0) wsf[32 + r32] = 1.0f / lrun;
    asm volatile("s_waitcnt lgkmcnt(0)" ::: "memory");
    float rli[16];
#pragma unroll
    for (int r = 0; r < 16; ++r) rli[r] = wsf[32 + crow(r, hi)];
    LAS float* X = (LAS float*)(lds + L_X) + wq * 4096;
    if (c == 1) {
#pragma unroll
        for (int d0 = 0; d0 < 4; ++d0)
#pragma unroll
            for (int r = 0; r < 16; ++r) X[(d0 * 16 + r) * 64 + lane] = o[d0][r] * rli[r];
    }
    __syncthreads();
    if (c == 0) {
        float ss[16];
#pragma unroll
        for (int r = 0; r < 16; ++r) { float s = 0.f;
#pragma unroll
            for (int d0 = 0; d0 < 4; ++d0) { const float v = o[d0][r] * rli[r] - lam * X[(d0 * 16 + r) * 64 + lane]; o[d0][r] = v; s += v * v; }
            ss[r] = s; }
#pragma unroll
        for (int r = 0; r < 16; ++r) {
#pragma unroll
            for (int off = 1; off < 32; off <<= 1) ss[r] += __shfl_xor(ss[r], off);
            ss[r] = 1.f / sqrtf(ss[r] * (1.f / 128.f) + NORM_EPS); }
        asm volatile("s_waitcnt lgkmcnt(0)" ::: "memory");
        LAS bf16* stg = (LAS bf16*)(lds + L_X + wq * 16384);
        float sw[4];
#pragma unroll
        for (int d0 = 0; d0 < 4; ++d0) sw[d0] = subw[32 * d0 + r32] * 0.8f;
#pragma unroll
        for (int r = 0; r < 16; ++r)
#pragma unroll
            for (int d0 = 0; d0 < 4; ++d0) stg[crow(r, hi) * 128 + 32 * d0 + r32] = (bf16)f2bf(o[d0][r] * ss[r] * sw[d0]);
    }
    __syncthreads();
    {
#pragma unroll
        for (int i = 0; i < 4; ++i) { const int id = tid + 512 * i, row = id >> 4, ch = id & 15;
            const v4u v = *(LAS const v4u*)(lds + L_X + (row >> 5) * 16384 + (row & 31) * 256 + ch * 16);
            *(GAS v4u*)(DO + (size_t)(b * SEQ + 128 * qb + row) * D + h * 128 + ch * 8) = v; }
    }
    __syncthreads();
}
}
namespace rk {
constexpr int LD64 = 72, LD128 = 136, LDF = 68;
constexpr int M64 = 64 * LD64 * 2  , M128 = 64 * LD128 * 2  , MF = 64 * LDF * 4  ;
constexpr int R1 = 0;
constexpr int O_TXW = R1, O_XA = R1 + M64, O_SXG = R1 + 2 * M64;
constexpr int O_LAB = R1, O_LAK = R1 + M64, O_LRB = R1 + 2 * M64, O_LRK = R1 + 3 * M64;
constexpr int R2 = R1 + 4 * M64;
constexpr int O_LC = R2, O_AA = R2 + MF;
constexpr int O_TL = R2, O_YS = R2 + M64, O_X1 = R2 + 2 * M64, O_AP = R2 + 3 * M64, O_WW = R2 + 4 * M64, O_YF = O_LAB;
constexpr int FX = R2 + 5 * M64;
constexpr int O_AT = FX, O_BT = FX + M64, O_KT = FX + 2 * M64, O_RT = FX + 3 * M64, O_VM = FX + 4 * M64, O_GG = FX + 5 * M64, O_SB = FX + 6 * M64;
constexpr int O_SB2 = FX + 7 * M64;
constexpr int O_SEG = O_SB2 + M64, O_BS = O_SEG + 2048, O_PCV = O_BS + 256, O_CONST = O_PCV + 256, O_END = O_CONST + 14 * 256;
static_assert(O_END <= LDSCTL_OFF && O_LAK == O_LAB + M64 && MF <= 2 * M64 && 2 * M64 + M128 <= 4 * M64 && 2 * MF <= 5 * M64, "rwkv LDS map");
enum { C_W0 = 0, C_A0, C_KK, C_KA, C_RK, C_LNW, C_LNB, C_MUR, C_MUK, C_MUV, C_MUW, C_MUA, C_MUG   };

typedef LAS unsigned char* lptr;
__device__ __forceinline__ bf16x8 ldA(lptr base, int ld, int m0, int k0, int lane) { return *(LAS const bf16x8*)(base + ((m0 + (lane & 15)) * ld + k0 + 8 * (lane >> 4)) * 2); }
__device__ __forceinline__ s16x4 vtr(lptr p) { typedef short v4i16_t __attribute__((ext_vector_type(4))); return __builtin_bit_cast(s16x4, __builtin_amdgcn_ds_read_tr16_b64_v4i16((LAS v4i16_t*)p)); }
__device__ __forceinline__ bf16x8 ldT(lptr base, int ld, int k0, int n0, int lane) {
    const int g = lane >> 4, q = (lane & 15) >> 2, p = lane & 3;
    lptr a = base + ((k0 + 8 * g + q) * ld + n0 + 4 * p) * 2;
    const s16x4 lo = vtr(a), hi = vtr(a + 4 * ld * 2);
    return (bf16x8){lo[0], lo[1], lo[2], lo[3], hi[0], hi[1], hi[2], hi[3]};
}
#define RK_MFMA(a, b, c) __builtin_amdgcn_mfma_f32_16x16x32_bf16((a), (b), (c), 0, 0, 0)
__device__ __forceinline__ void st16(lptr base, int ld, int m0, int n0, int lane, const f32x4& v) {
    LAS bf16* p = (LAS bf16*)base + (m0 + 4 * (lane >> 4)) * ld + n0 + (lane & 15);
#pragma unroll
    for (int i = 0; i < 4; ++i) p[i * ld] = (bf16)f2bf(v[i]);
}
__device__ __forceinline__ void unpack8(const v4u& w, float* f) { f[0] = bflo(w.x); f[1] = bfhi(w.x); f[2] = bflo(w.y); f[3] = bfhi(w.y); f[4] = bflo(w.z); f[5] = bfhi(w.z); f[6] = bflo(w.w); f[7] = bfhi(w.w); }
__device__ __forceinline__ v4u pack8(const float* f) { v4u o; o.x = pk2(f[0], f[1]); o.y = pk2(f[2], f[3]); o.z = pk2(f[4], f[5]); o.w = pk2(f[6], f[7]); return o; }
__device__ __forceinline__ void ldc8(lptr lds, int cidx, int off, float* f) { const f32x4 a = *(LAS const f32x4*)(lds + O_CONST + cidx * 256 + off * 4), b = *(LAS const f32x4*)(lds + O_CONST + cidx * 256 + off * 4 + 16);
    f[0] = a.x; f[1] = a.y; f[2] = a.z; f[3] = a.w; f[4] = b.x; f[5] = b.y; f[6] = b.z; f[7] = b.w; }

struct Params { const bf16* PR; bf16* RO; const float* mu; const float* w0; const float* a0; const float* kk; const float* ka; const float* rk; const float* lnw; const float* lnb; const bf16* W2T; const bf16* A2T; const bf16* G2T; };

__device__ __forceinline__ void run(lptr lds, const Params& P, int b, int h) {
    int tid = threadIdx.x, lane, wid, et, oct, g4, l15, mt, nt0;
#define RK_STAGE() do { asm volatile("" : "+v"(tid)); lane = tid & 63; wid = __builtin_amdgcn_readfirstlane(tid >> 6); et = tid >> 3; oct = tid & 7; g4 = lane >> 4; l15 = lane & 15; mt = wid >> 1; nt0 = 2 * (wid & 1); } while (0)
    RK_STAGE();
    if (tid < 64) { LAS float* C = (LAS float*)(lds + O_CONST); const int n = h * 64 + tid;
        C[C_W0 * 64 + tid] = P.w0[n]; C[C_A0 * 64 + tid] = P.a0[n]; C[C_KK * 64 + tid] = P.kk[n]; C[C_KA * 64 + tid] = P.ka[n]; C[C_RK * 64 + tid] = P.rk[n]; C[C_LNW * 64 + tid] = P.lnw[n]; C[C_LNB * 64 + tid] = P.lnb[n];
        C[C_MUR * 64 + tid] = P.mu[n]; C[C_MUK * 64 + tid] = P.mu[1024 + n]; C[C_MUV * 64 + tid] = P.mu[2048 + n]; C[C_MUW * 64 + tid] = P.mu[3072 + tid]; C[C_MUA * 64 + tid] = P.mu[3136 + tid];
        C[C_MUG * 64 + tid] = P.mu[3200 + tid]; C[C_MUG * 64 + 64 + tid] = P.mu[3264 + tid]; }
    for (int i = tid; i < M64 / 4; i += NTHREADS) { ((LAS unsigned*)(lds + O_SB))[i] = 0u; ((LAS unsigned*)(lds + O_SB2))[i] = 0u; }
    bf16x8 wf[4];
    if (wid < 4) { const int n = h * 64 + 16 * wid + l15;
#pragma unroll
        for (int ks = 0; ks < 2; ++ks) { wf[ks] = *(const GAS bf16x8*)(P.W2T + (size_t)n * 64 + 32 * ks + 8 * g4); wf[2 + ks] = *(const GAS bf16x8*)(P.A2T + (size_t)n * 64 + 32 * ks + 8 * g4); } }
    else { const int n = h * 64 + 16 * (wid - 4) + l15;
#pragma unroll
        for (int ks = 0; ks < 4; ++ks) wf[ks] = *(const GAS bf16x8*)(P.G2T + (size_t)n * 128 + 32 * ks + 8 * g4); }
    f32x4 s0 = {0.f, 0.f, 0.f, 0.f}, s1 = {0.f, 0.f, 0.f, 0.f};
    __syncthreads();
    v4u lc_[7], lp_[7];
#define RK_ISSUE(cc) do { const bool valid_ = ((cc) > 0) || (et < NMETA); const int rowc_ = ((cc) == 0) ? (MX + et) : (b * SEQ + 64 * ((cc) - 1) + et); const bool hasprev_ = !((cc) == 0 && et == 0); \
        const int rowp_ = ((cc) == 1 && et == 0) ? (MX + NMETA - 1) : rowc_ - 1; \
        const bf16* pc_ = P.PR + (size_t)(valid_ ? rowc_ : MX) * RW_COLS; const bf16* pp_ = P.PR + (size_t)((valid_ && hasprev_) ? rowp_ : MX) * RW_COLS; \
        const int co_[7] = {h * 64 + 8 * oct, 1024 + h * 64 + 8 * oct, 2048 + h * 64 + 8 * oct, 3072 + 8 * oct, 3136 + 8 * oct, 3200 + 16 * oct, 3208 + 16 * oct}; \
        _Pragma("unroll") for (int q = 0; q < 7; ++q) { lc_[q] = *(const GAS v4u*)(pc_ + co_[q]); lp_[q] = *(const GAS v4u*)(pp_ + co_[q]); } } while (0)
    RK_ISSUE(0);
    for (int c = 0; c <= 32; ++c) {
        const int o_sb = (c & 1) ? O_SB2 : O_SB, o_sbn = (c & 1) ? O_SB : O_SB2;
        RK_STAGE();
        const bool valid = (c > 0) || (et < NMETA);
        const int rowc = (c == 0) ? (MX + et) : (b * SEQ + 64 * (c - 1) + et);
        const bool hasprev = !(c == 0 && et == 0);
        const int rowp = (c == 1 && et == 0) ? (MX + NMETA - 1) : rowc - 1;
        float rr[8], kr[8], vr[8];
        {
            const float fv = valid ? 1.f : 0.f, fp = (valid && hasprev) ? 1.f : 0.f;
#define RK_LERP(dst, q, cidx, coff) do { float cu[8], pv[8], mm[8]; unpack8(lc_[q], cu); unpack8(lp_[q], pv); ldc8(lds, cidx, coff, mm); \
            _Pragma("unroll") for (int j = 0; j < 8; ++j) { const float c_ = cu[j] * fv; dst[j] = c_ + (pv[j] * fp - c_) * mm[j]; } } while (0)
            RK_LERP(rr, 0, C_MUR, 8 * oct); RK_LERP(kr, 1, C_MUK, 8 * oct); RK_LERP(vr, 2, C_MUV, 8 * oct);
            float xw[8], xa[8], xg0[8], xg1[8];
            RK_LERP(xw, 3, C_MUW, 8 * oct); RK_LERP(xa, 4, C_MUA, 8 * oct); RK_LERP(xg0, 5, C_MUG, 16 * oct); RK_LERP(xg1, 6, C_MUG, 16 * oct + 8);
#undef RK_LERP
            if (c < 32) RK_ISSUE(c + 1);
#pragma unroll
            for (int j = 0; j < 8; ++j) { xw[j] = 1.0f - 2.0f * __builtin_amdgcn_rcpf(1.0f + __expf(2.0f * xw[j])); xg0[j] = __builtin_amdgcn_rcpf(1.0f + __expf(-xg0[j])); xg1[j] = __builtin_amdgcn_rcpf(1.0f + __expf(-xg1[j])); }
            *(LAS v4u*)(lds + O_TXW + (et * LD64 + 8 * oct) * 2) = pack8(xw);
            *(LAS v4u*)(lds + O_XA + (et * LD64 + 8 * oct) * 2) = pack8(xa);
            *(LAS v4u*)(lds + O_SXG + (et * LD128 + 16 * oct) * 2) = pack8(xg0);
            *(LAS v4u*)(lds + O_SXG + (et * LD128 + 16 * oct + 8) * 2) = pack8(xg1);
        }
        __syncthreads();
        RK_STAGE();
        if (wid < 4) {
            const int k = 16 * wid + l15; const float w0k = ((LAS const float*)(lds + O_CONST))[C_W0 * 64 + k], a0k = ((LAS const float*)(lds + O_CONST))[C_A0 * 64 + k];
#pragma unroll
            for (int m = 0; m < 4; ++m) {
                f32x4 aw = {0.f, 0.f, 0.f, 0.f}, aa = {0.f, 0.f, 0.f, 0.f};
#pragma unroll
                for (int ks = 0; ks < 2; ++ks) { aw = RK_MFMA(ldA(lds + O_TXW, LD64, 16 * m, 32 * ks, lane), wf[ks], aw); aa = RK_MFMA(ldA(lds + O_XA, LD64, 16 * m, 32 * ks, lane), wf[2 + ks], aa); }
#pragma unroll
                for (int i = 0; i < 4; ++i) { const int t = 16 * m + 4 * g4 + i;
                    ((LAS float*)(lds + O_LC))[t * LDF + k] = w0k + aw[i];
                    ((LAS float*)(lds + O_AA))[t * LDF + k] = a0k + aa[i]; }
            }
        } else {
            const int n0 = 16 * (wid - 4);
#pragma unroll
            for (int m = 0; m < 4; ++m) { f32x4 ag = {0.f, 0.f, 0.f, 0.f};
#pragma unroll
                for (int ks = 0; ks < 4; ++ks) ag = RK_MFMA(ldA(lds + O_SXG, LD128, 16 * m, 32 * ks, lane), wf[ks], ag);
                st16(lds + O_GG, LD64, 16 * m, n0, lane, ag); }
        }
        __syncthreads();
        RK_STAGE();
        float aa8[8];
        {
            LAS f32x4* lcp = (LAS f32x4*)(lds + O_LC + (et * LDF + 8 * oct) * 4); const LAS f32x4* aap = (const LAS f32x4*)(lds + O_AA + (et * LDF + 8 * oct) * 4);
            f32x4 w0_ = lcp[0], w1_ = lcp[1]; const f32x4 a0_ = aap[0], a1_ = aap[1];
            const float fvd = ((c > 0) || (et < NMETA)) ? -0.6065306597126334f : 0.f;
#pragma unroll
            for (int j = 0; j < 4; ++j) { w0_[j] = fvd * __builtin_amdgcn_rcpf(1.0f + __expf(-w0_[j])); w1_[j] = fvd * __builtin_amdgcn_rcpf(1.0f + __expf(-w1_[j]));
                aa8[j] = __builtin_amdgcn_rcpf(1.0f + __expf(-a0_[j])); aa8[4 + j] = __builtin_amdgcn_rcpf(1.0f + __expf(-a1_[j])); }
            lcp[0] = w0_; lcp[1] = w1_;
        }
        __syncthreads();
        RK_STAGE();
        { const int k = tid & 63, seg = tid >> 6; LAS float* LC = (LAS float*)(lds + O_LC); float x[8];
#pragma unroll
          for (int j = 0; j < 8; ++j) x[j] = LC[(8 * seg + j) * LDF + k];
#pragma unroll
          for (int j = 1; j < 8; ++j) x[j] += x[j - 1];
          ((LAS float*)(lds + O_SEG))[seg * 64 + k] = x[7];
          __syncthreads();
          float sg[8];
#pragma unroll
          for (int s2 = 0; s2 < 7; ++s2) sg[s2] = ((LAS const float*)(lds + O_SEG))[s2 * 64 + k];
          float off = 0.f;
#pragma unroll
          for (int s2 = 0; s2 < 7; ++s2) off += (s2 < seg) ? sg[s2] : 0.f;
#pragma unroll
          for (int j = 0; j < 8; ++j) LC[(8 * seg + j) * LDF + k] = x[j] + off; }
        __syncthreads();
        RK_STAGE();
        {
            float lc[8], lp[8], aa[8], ck[8];
            { const f32x4 a = *(LAS const f32x4*)(lds + O_LC + (et * LDF + 8 * oct) * 4), b2 = *(LAS const f32x4*)(lds + O_LC + (et * LDF + 8 * oct) * 4 + 16);
              lc[0] = a.x; lc[1] = a.y; lc[2] = a.z; lc[3] = a.w; lc[4] = b2.x; lc[5] = b2.y; lc[6] = b2.z; lc[7] = b2.w; }
            if (et > 0) { const f32x4 a = *(LAS const f32x4*)(lds + O_LC + ((et - 1) * LDF + 8 * oct) * 4), b2 = *(LAS const f32x4*)(lds + O_LC + ((et - 1) * LDF + 8 * oct) * 4 + 16);
              lp[0] = a.x; lp[1] = a.y; lp[2] = a.z; lp[3] = a.w; lp[4] = b2.x; lp[5] = b2.y; lp[6] = b2.z; lp[7] = b2.w; }
            else {
#pragma unroll
              for (int j = 0; j < 8; ++j) lp[j] = 0.f; }
#pragma unroll
            for (int j = 0; j < 8; ++j) aa[j] = aa8[j];
            ldc8(lds, C_KK, 8 * oct, ck);
            float kk[8], ss = 0.f;
#pragma unroll
            for (int j = 0; j < 8; ++j) { kk[j] = kr[j] * ck[j]; ss += kk[j] * kk[j]; }
            ss += __shfl_xor(ss, 1); ss += __shfl_xor(ss, 2); ss += __shfl_xor(ss, 4);
            const float rn = __builtin_amdgcn_rcpf(fmaxf(sqrtf(ss), 1e-12f));
            ldc8(lds, C_KA, 8 * oct, ck);
            float kp[8], at[8], bt[8], kt[8], rt[8];
#pragma unroll
            for (int j = 0; j < 8; ++j) { kk[j] *= rn; kp[j] = kr[j] * (1.0f + (aa[j] - 1.0f) * ck[j]);
                const float eP = __expf(lp[j]), eC = __expf(lc[j]), eN = __builtin_amdgcn_rcpf(eC);
                at[j] = -kk[j] * eP; bt[j] = kk[j] * aa[j] * eN; kt[j] = kp[j] * eN; rt[j] = rr[j] * eC;
                if (et == 63) ((LAS float*)(lds + O_PCV))[8 * oct + j] = eC; }
            ldc8(lds, C_RK, 8 * oct, ck);
            float bsum = 0.f;
#pragma unroll
            for (int j = 0; j < 8; ++j) bsum += rr[j] * kp[j] * ck[j];
            bsum += __shfl_xor(bsum, 1); bsum += __shfl_xor(bsum, 2); bsum += __shfl_xor(bsum, 4);
            if (oct == 0) ((LAS float*)(lds + O_BS))[et] = bsum;
            *(LAS v4u*)(lds + O_AT + (et * LD64 + 8 * oct) * 2) = pack8(at);
            *(LAS v4u*)(lds + O_BT + (et * LD64 + 8 * oct) * 2) = pack8(bt);
            *(LAS v4u*)(lds + O_KT + (et * LD64 + 8 * oct) * 2) = pack8(kt);
            *(LAS v4u*)(lds + O_RT + (et * LD64 + 8 * oct) * 2) = pack8(rt);
            *(LAS v4u*)(lds + O_VM + (et * LD64 + 8 * oct) * 2) = pack8(vr);
        }
        __syncthreads();
        RK_STAGE();
        { const v4u z4 = {0u, 0u, 0u, 0u}; for (int i = tid; i < 2 * M64 / 16; i += NTHREADS) *(LAS v4u*)(lds + O_TL + i * 16) = z4; }
        {
#pragma unroll
            for (int q = 0; q < 2; ++q) { const int nt = nt0 + q;
                f32x4 cab = {0.f, 0.f, 0.f, 0.f}, cak = cab, crb = cab, crk = cab;
                if (nt <= mt) {
#pragma unroll
                    for (int ks = 0; ks < 2; ++ks) { const bf16x8 fa = ldA(lds + O_AT, LD64, 16 * mt, 32 * ks, lane), fr = ldA(lds + O_RT, LD64, 16 * mt, 32 * ks, lane), fb = ldA(lds + O_BT, LD64, 16 * nt, 32 * ks, lane), fk = ldA(lds + O_KT, LD64, 16 * nt, 32 * ks, lane);
                        cab = RK_MFMA(fa, fb, cab); cak = RK_MFMA(fa, fk, cak); crb = RK_MFMA(fr, fb, crb); crk = RK_MFMA(fr, fk, crk); }
#pragma unroll
                    for (int i = 0; i < 4; ++i) { const int t = 16 * mt + 4 * g4 + i, ii = 16 * nt + l15; if (!(t > ii)) { cab[i] = 0.f; cak[i] = 0.f; } if (!(t >= ii)) { crb[i] = 0.f; crk[i] = 0.f; } }
                }
                st16(lds + O_LAB, LD64, 16 * mt, 16 * nt, lane, cab); st16(lds + O_LAK, LD64, 16 * mt, 16 * nt, lane, cak); st16(lds + O_LRB, LD64, 16 * mt, 16 * nt, lane, crb); st16(lds + O_LRK, LD64, 16 * mt, 16 * nt, lane, crk); }
        }
        __syncthreads();
        RK_STAGE();
        if (wid == 0) {
            { const int blk = g4, cc = l15; v4u Lr[16][2];
#pragma unroll
              for (int r = 1; r < 16; ++r) { Lr[r][0] = *(LAS const v4u*)(lds + O_LAB + ((16 * blk + r) * LD64 + 16 * blk) * 2); Lr[r][1] = *(LAS const v4u*)(lds + O_LAB + ((16 * blk + r) * LD64 + 16 * blk + 8) * 2); }
              float T[16];
#pragma unroll
              for (int r = 0; r < 16; ++r) { float acc = (r == cc) ? 1.f : 0.f;
#pragma unroll
                  for (int j = 0; j < r; ++j) { const unsigned w = Lr[r][j >> 3][(j >> 1) & 3]; const float lv = (j & 1) ? bfhi(w) : bflo(w); acc += lv * T[j]; }
                  T[r] = acc; }
#pragma unroll
              for (int r = 0; r < 16; ++r) ((LAS bf16*)(lds + O_TL))[(16 * blk + r) * LD64 + 16 * blk + cc] = (bf16)f2bf(T[r]); }
            asm volatile("s_waitcnt lgkmcnt(0)" ::: "memory");
            const f32x4 z = {0.f, 0.f, 0.f, 0.f};
#pragma unroll
            for (int pp = 0; pp < 2; ++pp) { const f32x4 y1 = RK_MFMA(ldA(lds + O_LAB, LD64, 32 * pp + 16, 32 * pp, lane), ldT(lds + O_TL, LD64, 32 * pp, 32 * pp, lane), z); st16(lds + O_YS, LD64, 32 * pp + 16, 32 * pp, lane, y1); }
            asm volatile("s_waitcnt lgkmcnt(0)" ::: "memory");
            f32x4 t21[2];
#pragma unroll
            for (int pp = 0; pp < 2; ++pp) t21[pp] = RK_MFMA(ldA(lds + O_TL, LD64, 32 * pp + 16, 32 * pp, lane), ldT(lds + O_YS, LD64, 32 * pp, 32 * pp, lane), z);
            asm volatile("s_waitcnt lgkmcnt(0)" ::: "memory");
#pragma unroll
            for (int pp = 0; pp < 2; ++pp) st16(lds + O_TL, LD64, 32 * pp + 16, 32 * pp, lane, t21[pp]);
            asm volatile("s_waitcnt lgkmcnt(0)" ::: "memory");
#pragma unroll
            for (int a = 0; a < 2; ++a)
#pragma unroll
                for (int bq = 0; bq < 2; ++bq) { const f32x4 y2 = RK_MFMA(ldA(lds + O_LAB, LD64, 32 + 16 * a, 0, lane), ldT(lds + O_TL, LD64, 0, 16 * bq, lane), z); st16(lds + O_YS, LD64, 32 + 16 * a, 16 * bq, lane, y2); }
            asm volatile("s_waitcnt lgkmcnt(0)" ::: "memory");
            f32x4 t2[2][2];
#pragma unroll
            for (int a = 0; a < 2; ++a)
#pragma unroll
                for (int bq = 0; bq < 2; ++bq) t2[a][bq] = RK_MFMA(ldA(lds + O_TL, LD64, 32 + 16 * a, 32, lane), ldT(lds + O_YS, LD64, 32, 16 * bq, lane), z);
            asm volatile("s_waitcnt lgkmcnt(0)" ::: "memory");
#pragma unroll
            for (int a = 0; a < 2; ++a)
#pragma unroll
                for (int bq = 0; bq < 2; ++bq) st16(lds + O_TL, LD64, 32 + 16 * a, 16 * bq, lane, t2[a][bq]);
        } else {
            for (int q = wid - 1; q < 16; q += 7) { const int m = q >> 2, n = q & 3; f32x4 acc = {0.f, 0.f, 0.f, 0.f};
#pragma unroll
                for (int ks = 0; ks < 2; ++ks) acc = RK_MFMA(ldA(lds + O_LAK, LD64, 16 * m, 32 * ks, lane), ldT(lds + O_VM, LD64, 32 * ks, 16 * n, lane), acc);
                st16(lds + O_X1, LD64, 16 * m, 16 * n, lane, acc); }
        }
        __syncthreads();
        RK_STAGE();
        f32x4 wl[2];
        {
            bf16x8 ft[2]; ft[0] = ldA(lds + O_TL, LD64, 16 * mt, 0, lane); ft[1] = ldA(lds + O_TL, LD64, 16 * mt, 32, lane);
#pragma unroll
            for (int q = 0; q < 2; ++q) { const int nt = nt0 + q; f32x4 ap = {0.f, 0.f, 0.f, 0.f}; wl[q] = ap;
#pragma unroll
                for (int ks = 0; ks < 2; ++ks) { ap = RK_MFMA(ft[ks], ldT(lds + O_AT, LD64, 32 * ks, 16 * nt, lane), ap); wl[q] = RK_MFMA(ft[ks], ldT(lds + O_X1, LD64, 32 * ks, 16 * nt, lane), wl[q]); }
                st16(lds + O_AP, LD64, 16 * mt, 16 * nt, lane, ap); }
        }
        __syncthreads();
        RK_STAGE();
        {
#pragma unroll
            for (int q = 0; q < 2; ++q) { const int nt = nt0 + q;
#pragma unroll
                for (int ks = 0; ks < 2; ++ks) wl[q] = RK_MFMA(ldA(lds + O_AP, LD64, 16 * mt, 32 * ks, lane), ldA(lds + o_sb, LD64, 16 * nt, 32 * ks, lane), wl[q]);
                st16(lds + O_WW, LD64, 16 * mt, 16 * nt, lane, wl[q]); }
        }
        __syncthreads();
        RK_STAGE();
        {
#pragma unroll
            for (int q = 0; q < 2; ++q) { const int nt = nt0 + q; f32x4 y = {0.f, 0.f, 0.f, 0.f};
#pragma unroll
                for (int ks = 0; ks < 2; ++ks) { y = RK_MFMA(ldA(lds + O_RT, LD64, 16 * mt, 32 * ks, lane), ldA(lds + o_sb, LD64, 16 * nt, 32 * ks, lane), y);
                    y = RK_MFMA(ldA(lds + O_LRK, LD64, 16 * mt, 32 * ks, lane), ldT(lds + O_VM, LD64, 32 * ks, 16 * nt, lane), y);
                    y = RK_MFMA(ldA(lds + O_LRB, LD64, 16 * mt, 32 * ks, lane), ldT(lds + O_WW, LD64, 32 * ks, 16 * nt, lane), y); }
                wl[q] = y; }
            f32x4 d0 = {0.f, 0.f, 0.f, 0.f}, d1 = d0;
#pragma unroll
            for (int ks = 0; ks < 2; ++ks) { const bf16x8 fw = ldT(lds + O_WW, LD64, 32 * ks, 16 * mt, lane), fv = ldT(lds + O_VM, LD64, 32 * ks, 16 * mt, lane);
                d0 = RK_MFMA(fw, ldT(lds + O_BT, LD64, 32 * ks, 16 * nt0, lane), d0); d0 = RK_MFMA(fv, ldT(lds + O_KT, LD64, 32 * ks, 16 * nt0, lane), d0);
                d1 = RK_MFMA(fw, ldT(lds + O_BT, LD64, 32 * ks, 16 * nt0 + 16, lane), d1); d1 = RK_MFMA(fv, ldT(lds + O_KT, LD64, 32 * ks, 16 * nt0 + 16, lane), d1); }
            const float pc0 = ((LAS const float*)(lds + O_PCV))[16 * nt0 + l15], pc1 = ((LAS const float*)(lds + O_PCV))[16 * nt0 + 16 + l15];
            s0 = (s0 + d0) * pc0; s1 = (s1 + d1) * pc1;
        }
        {
#pragma unroll
            for (int q = 0; q < 2; ++q) { LAS float* yp = (LAS float*)(lds + O_YF) + (16 * mt + 4 * g4) * LDF + 16 * (nt0 + q) + l15;
#pragma unroll
                for (int i = 0; i < 4; ++i) yp[i * LDF] = wl[q][i]; }
            st16(lds + o_sbn, LD64, 16 * mt, 16 * nt0, lane, s0); st16(lds + o_sbn, LD64, 16 * mt, 16 * nt0 + 16, lane, s1);
        }
        __syncthreads();
        RK_STAGE();
        if (c > 0) {
            float y[8], gg[8], lw[8], lb[8];
            { const f32x4 a = *(LAS const f32x4*)(lds + O_YF + (et * LDF + 8 * oct) * 4), b2 = *(LAS const f32x4*)(lds + O_YF + (et * LDF + 8 * oct) * 4 + 16);
              y[0] = a.x; y[1] = a.y; y[2] = a.z; y[3] = a.w; y[4] = b2.x; y[5] = b2.y; y[6] = b2.z; y[7] = b2.w; }
            float sm = 0.f;
#pragma unroll
            for (int j = 0; j < 8; ++j) sm += y[j];
            sm += __shfl_xor(sm, 1); sm += __shfl_xor(sm, 2); sm += __shfl_xor(sm, 4);
            const float mean = sm * (1.f / 64.f); float sv = 0.f;
#pragma unroll
            for (int j = 0; j < 8; ++j) { y[j] -= mean; sv += y[j] * y[j]; }
            sv += __shfl_xor(sv, 1); sv += __shfl_xor(sv, 2); sv += __shfl_xor(sv, 4);
            const float rstd = 1.0f / sqrtf(sv * (1.f / 64.f) + 64e-5f);
            { const v4u t_ = *(LAS const v4u*)(lds + O_GG + (et * LD64 + 8 * oct) * 2); unpack8(t_, gg); } ldc8(lds, C_LNW, 8 * oct, lw); ldc8(lds, C_LNB, 8 * oct, lb);
            const float bsv = ((LAS const float*)(lds + O_BS))[et];
            float o[8];
#pragma unroll
            for (int j = 0; j < 8; ++j) o[j] = (y[j] * rstd * lw[j] + lb[j] + bsv * vr[j]) * gg[j];
            *(GAS v4u*)(P.RO + (size_t)rowc * D + h * 64 + 8 * oct) = pack8(o);
        }
        __syncthreads();
    }
}
#undef RK_STAGE
#undef RK_ISSUE
}
constexpr int MOE_CAP = 40960, MOE_MAXT = 160;
constexpr int RW_CNT = CW_ROUTE  , RW_CUR = CW_ROUTE + 2048  , RW_NT = CW_ROUTE + 4096, RW_TE = CW_ROUTE + 4160  ;
constexpr int RW_TOKK = 65536  , RW_GATE = RW_TOKK + MOE_CAP  ;
static_assert((RW_GATE + MOE_CAP) * 4 <= (int)CTL_ZERO_BYTES, "route tables inside CTL");
constexpr size_t WS_TE = WS_SMALL + 512 * 1024, WS_TG = WS_TE + 128 * 1024;

__device__ __forceinline__ float grp16_sum(float v) { v += __shfl_xor(v, 1); v += __shfl_xor(v, 2); v += __shfl_xor(v, 4); v += __shfl_xor(v, 8); return v; }
__device__ __forceinline__ void moe_row4(const float* h2, const float* n2w, bf16* xn2, const float* wg, const float* bg, const float* we, const float* be, int* te, float* tg, int mbase, LAS unsigned* hist, int lane) {
    const int l16 = lane & 15, m = mbase + (lane >> 4);
    const GAS f32x4* xr = (const GAS f32x4*)(h2 + (size_t)m * D) + l16; const GAS f32x4* wr = (const GAS f32x4*)n2w + l16;
    float s2 = 0.f;
#pragma unroll 1
    for (int c = 0; c < 2; ++c) { f32x4 v[8];
#pragma unroll
        for (int j = 0; j < 8; ++j) v[j] = xr[16 * (8 * c + j)];
#pragma unroll
        for (int j = 0; j < 8; ++j) s2 += (v[j].x * v[j].x + v[j].y * v[j].y) + (v[j].z * v[j].z + v[j].w * v[j].w); }
    const float rstd = 1.f / sqrtf(grp16_sum(s2) * (1.f / D) + NORM_EPS);
    GAS unsigned long long* o8 = (GAS unsigned long long*)(xn2 + (size_t)m * D) + l16;
    float lg[4] = {0.f, 0.f, 0.f, 0.f};
#pragma unroll 1
    for (int c = 0; c < 4; ++c) { f32x4 v[4], g[4], w4[4][4];
        const GAS f32x4* wgp = (const GAS f32x4*)wg + 4 * (l16 + 64 * c);
#pragma unroll
        for (int j = 0; j < 4; ++j) { v[j] = xr[16 * (4 * c + j)]; g[j] = wr[16 * (4 * c + j)]; }
#pragma unroll
        for (int j = 0; j < 4; ++j)
#pragma unroll
            for (int i = 0; i < 4; ++i) w4[j][i] = wgp[64 * j + i];
#pragma unroll
        for (int j = 0; j < 4; ++j) { v[j] = v[j] * rstd * g[j]; o8[16 * (4 * c + j)] = (unsigned long long)pk2(v[j].x, v[j].y) | ((unsigned long long)pk2(v[j].z, v[j].w) << 32);
#pragma unroll
            for (int i = 0; i < 4; ++i) { const float u = v[j][i]; lg[0] += u * w4[j][i].x; lg[1] += u * w4[j][i].y; lg[2] += u * w4[j][i].z; lg[3] += u * w4[j][i].w; } } }
#pragma unroll
    for (int q = 0; q < 4; ++q) lg[q] = grp16_sum(lg[q]) + bg[q];
    int gi = 0; float gm = lg[0];
#pragma unroll
    for (int q = 1; q < 4; ++q) if (lg[q] > gm) { gm = lg[q]; gi = q; }
    float gs = 0.f;
#pragma unroll
    for (int q = 0; q < 4; ++q) gs += __expf(lg[q] - gm);
    const float gval = 1.0f / gs;
    float le[8];
#pragma unroll
    for (int q = 0; q < 8; ++q) le[q] = 0.f;
#pragma unroll 1
    for (int c = 0; c < 8; ++c) { f32x4 v[2], g[2], wa[2][4], wb[2][4];
        const GAS f32x4* wep = (const GAS f32x4*)(we + (size_t)(4 * (l16 + 32 * c)) * 32 + gi * 8);
#pragma unroll
        for (int j = 0; j < 2; ++j) { v[j] = xr[16 * (2 * c + j)]; g[j] = wr[16 * (2 * c + j)]; }
#pragma unroll
        for (int j = 0; j < 2; ++j)
#pragma unroll
            for (int i = 0; i < 4; ++i) { wa[j][i] = wep[(64 * j + i) * 8]; wb[j][i] = wep[(64 * j + i) * 8 + 1]; }
#pragma unroll
        for (int j = 0; j < 2; ++j) { v[j] = v[j] * rstd * g[j];
#pragma unroll
            for (int i = 0; i < 4; ++i) { const float u = v[j][i]; const f32x4 a = wa[j][i], b = wb[j][i];
                le[0] += u * a.x; le[1] += u * a.y; le[2] += u * a.z; le[3] += u * a.w; le[4] += u * b.x; le[5] += u * b.y; le[6] += u * b.z; le[7] += u * b.w; } } }
#pragma unroll
    for (int q = 0; q < 8; ++q) le[q] = grp16_sum(le[q]) + be[gi * 8 + q];
    int i1 = 0; float m1 = le[0];
#pragma unroll
    for (int q = 1; q < 8; ++q) if (le[q] > m1) { m1 = le[q]; i1 = q; }
    int i2 = -1; float m2 = -INFINITY;
#pragma unroll
    for (int q = 0; q < 8; ++q) if (q != i1 && le[q] > m2) { m2 = le[q]; i2 = q; }
    const float p2 = __expf(m2 - m1), inv = 1.0f / (1.0f + p2);
    if (l16 == 0) { te[2 * m] = gi * 8 + i1; te[2 * m + 1] = gi * 8 + i2; tg[2 * m] = gval * inv; tg[2 * m + 1] = gval * p2 * inv;
        __hip_atomic_fetch_add(hist + gi * 8 + i1, 1u, __ATOMIC_RELAXED, __HIP_MEMORY_SCOPE_WORKGROUP); __hip_atomic_fetch_add(hist + gi * 8 + i2, 1u, __ATOMIC_RELAXED, __HIP_MEMORY_SCOPE_WORKGROUP); }
}

namespace pg8 {
struct LinearAOrder {
    static constexpr bool GATHER = false;
    StaticOrder so; unsigned rowbytes;
    __device__ bool next(int i, Unit& u) const { return so.next(i, u); }
    __device__ __forceinline__ unsigned a_row_off(const Unit& u, int r) const { return (unsigned)(u.pm * BM + r) * rowbytes; }
};
struct MoeOrder {
    static constexpr bool GATHER = true;
    const int* tokk; const unsigned* tile_e; int ntile, G, c; bool gather; unsigned rowbytes;
    __device__ bool next(int i, Unit& u) const { const long L = (long)i * G + c; if (L >= 4L * ntile) return false; const int tile = (int)(L >> 2); u.pm = tile; u.pn = (int)tile_e[tile] * 4 + (int)(L & 3); return true; }
    __device__ __forceinline__ unsigned a_row_off(const Unit& u, int r) const {
        if (gather) { const int idx = tokk[u.pm * BM + r]; const int tok = idx < 0 ? MX : (idx >> 1); return (unsigned)tok * rowbytes; }
        return (unsigned)(u.pm * BM + r) * rowbytes; }
};
struct EpiSwiGLU {
    static constexpr bool PERM = true, AFTER_DRAIN = false;
    bf16_t* H;
    __device__ __forceinline__ void operator()(const f32x4 (&acc)[2][2][4][2], const Unit& u, int wr, int wc, int fr, int fq) const {
        const int row0 = u.pm * BM + wr * 64 + fr, col0 = (u.pn & 3) * 128 + wc * 32 + 8 * fq;
#pragma unroll
        for (int ai = 0; ai < 2; ++ai)
#pragma unroll
            for (int m = 0; m < 4; ++m) { const size_t row = row0 + ai * HALF + m * 16; f32x4 h0, h1;
#pragma unroll
                for (int e = 0; e < 4; ++e) { const float g0 = acc[ai][0][m][0][e], g1 = acc[ai][0][m][1][e];
                    h0[e] = g0 / (1.0f + __expf(-g0)) * acc[ai][1][m][0][e]; h1[e] = g1 / (1.0f + __expf(-g1)) * acc[ai][1][m][1][e]; }
                u32x4 w; w.x = cvt_pk_bf16(h0[0], h0[1]); w.y = cvt_pk_bf16(h0[2], h0[3]); w.z = cvt_pk_bf16(h1[0], h1[1]); w.w = cvt_pk_bf16(h1[2], h1[3]);
                *(u32x4*)(H + row * 512 + col0) = w; }
    }
};
struct EpiMoeDown {
    static constexpr bool PERM = false, AFTER_DRAIN = false;
    const int* tokk; const float* gate; float* O; bf16_t* Y1;
    __device__ __forceinline__ void operator()(const f32x4 (&acc)[2][2][4][2], const Unit& u, int wr, int wc, int fr, int fq) const {
        const int slot0 = u.pm * BM + wr * 64 + fr, col0 = (u.pn & 3) * BM + wc * 32 + 4 * fq;
        int tk[2][4]; float gt[2][4];
#pragma unroll
        for (int ai = 0; ai < 2; ++ai)
#pragma unroll
            for (int m = 0; m < 4; ++m) { const int slot = slot0 + ai * HALF + m * 16; tk[ai][m] = tokk[slot]; gt[ai][m] = gate[slot]; }
#pragma unroll
        for (int ai = 0; ai < 2; ++ai) {
            f32x4 old[4][2][2];
#pragma unroll
            for (int m = 0; m < 4; ++m) { const bool s0 = (tk[ai][m] >= 0) && ((tk[ai][m] & 1) == 0); const size_t off = s0 ? (size_t)(tk[ai][m] >> 1) * 1024 + col0 : (size_t)col0;
#pragma unroll
                for (int bj = 0; bj < 2; ++bj)
#pragma unroll
                    for (int n = 0; n < 2; ++n) old[m][bj][n] = *(const f32x4*)(O + off + bj * HALF + n * 16); }
#pragma unroll
            for (int m = 0; m < 4; ++m) { const int t = tk[ai][m];
                if (t >= 0) { const float g = gt[ai][m]; const size_t off = (size_t)(t >> 1) * 1024 + col0;
                    if ((t & 1) == 0) {
#pragma unroll
                        for (int bj = 0; bj < 2; ++bj)
#pragma unroll
                            for (int n = 0; n < 2; ++n) *(f32x4*)(O + off + bj * HALF + n * 16) = old[m][bj][n] + acc[ai][bj][m][n] * g;
                    } else {
#pragma unroll
                        for (int bj = 0; bj < 2; ++bj)
#pragma unroll
                            for (int n = 0; n < 2; ++n) { const f32x4 v = acc[ai][bj][m][n] * g; unsigned long long w = (unsigned long long)cvt_pk_bf16(v[0], v[1]) | ((unsigned long long)cvt_pk_bf16(v[2], v[3]) << 32);
                                *(unsigned long long*)(Y1 + off + bj * HALF + n * 16) = w; }
                    } } }
            asm volatile("" ::: "memory");
        }
    }
};
}
#define KP_U ((bf16*)args.out)
#define KP_WinT ((bf16*)(args.ws + WS_WIN))
#define KP_PR ((bf16*)(args.ws + WS_PR))
#define KP_PD ((bf16*)(args.ws + WS_PD))
#define KP_PG ((bf16*)(args.ws + WS_PG))
#define KP_RO ((bf16*)args.out)
#define KP_DO ((bf16*)args.out + (size_t)MX * D)
#define KP_MRG ((bf16*)(args.ws + WS_MRG))
#define KP_XN2 ((bf16*)(args.ws + WS_XN2))
#define KP_WGU ((bf16*)(args.ws + WS_WGU))
#define KP_WDN ((bf16*)(args.ws + WS_WDN))
#define KP_HID ((bf16*)(args.ws + WS_HID))
#define KP_Y1 ((bf16*)(args.ws + WS_Y1))
#define KP_te ((int*)(args.ws + WS_TE))
#define KP_tg ((float*)(args.ws + WS_TG))
#define KP_tokk ((int*)(args.ws + WS_CTL) + RW_TOKK)
#define KP_rgate ((float*)(args.ws + WS_CTL) + RW_GATE)
struct Args { const float* in[33]; float* out; unsigned char* ws; int pad0, pad1; };
__global__ void __launch_bounds__(NTHREADS, 2) fwd_kernel(Args args) {
    extern __shared__ __attribute__((aligned(16))) unsigned char lds_raw[];
    LAS unsigned char* lds = (LAS unsigned char*)lds_raw;
    volatile LAS unsigned* MISC = (volatile LAS unsigned*)(lds + MISC_OFF);
    const int tid = threadIdx.x, lane = tid & 63, wave = __builtin_amdgcn_readfirstlane(tid >> 6);
    const int G = gridDim.x, bx = blockIdx.x; const int vcu = (G % 8 == 0) ? (bx % 8) * (G / 8) + bx / 8 : bx;
    unsigned char* ws = args.ws; gu32* ctl = (gu32*)(ws + WS_CTL);
    for (int u = tid; u < (LDS_BYTES - LDSCTL_OFF) / 4; u += NTHREADS) ((LAS unsigned*)(lds + LDSCTL_OFF))[u] = 0u;
    __syncthreads();
    XcdBarrier bar = xcd_barrier_post((unsigned*)(ctl + CW_BAR), MISC + 8);
    const float* x = args.in[0]; float* out = args.out;
#if defined(PROBE_A)
    unsigned long long* tsw = (unsigned long long*)(ws + WS_CTL + 12000); int n_ts = 0;
#define STAMP() do { if (bx == 0 && tid == 0) tsw[n_ts] = __builtin_amdgcn_s_memrealtime(); ++n_ts; } while (0)
#else
#define STAMP() do {} while (0)
#endif
    STAMP();
#ifndef REP_PHASE
#define REP_PHASE -1
#endif
#define NREP(k) ((REP_PHASE) == (k) ? 2 : 1)
    const int gw = vcu * NWAVES + wave, NGW = G * NWAVES;

    for (int rep_ = 0; rep_ < NREP(0); ++rep_) {
    {
        LAS float* scr = (LAS float*)(lds + wave * 16384);
        const float* Win = args.in[3];
        constexpr int I_IN = (D / 64) * (IN_COLS / 32);
        for (int it = gw; it < I_IN; it += NGW) { const int nblk = IN_COLS / 32, kb = it / nblk, nb = it % nblk; int drow = 32 * nb;
            { const int cq = 32 * nb - RW_COLS; if (cq >= 0 && cq < 2048) { const int within = cq & 255; drow = RW_COLS + (cq & ~255) + 128 * ((within >> 5) & 1) + 32 * (within >> 6); } }
            transpose_item(Win, IN_COLS, KP_WinT, D, drow, 64 * kb, 32 * nb, scr, lane); }
        { float* cs = (float*)(ws + WS_SMALL + 768 * 1024);
          for (int i = bx * NTHREADS + tid; i < (SEQ + NMETA) * 8; i += G * NTHREADS) { const int pos = i >> 3, j = i & 7; const float invf = expf(-13.122363377404328f * (float)j * 2.0f / 16.0f); float sn, csn; sincosf((float)pos * invf, &sn, &csn); cs[pos * 16 + j] = csn; cs[pos * 16 + 8 + j] = sn; } }
        { const float* Ws[3] = {args.in[22], args.in[23], args.in[24]}; bf16* Wd[3] = {(bf16*)(ws + WS_WBR), (bf16*)(ws + WS_WBD), (bf16*)(ws + WS_WOUT)};
          constexpr int I_SQ = (D / 64) * (D / 32);
#pragma unroll
          for (int w = 0; w < 3; ++w) for (int it = gw; it < I_SQ; it += NGW) { const int kb = it / 32, nb = it % 32; transpose_item(Ws[w], D, Wd[w], D, 32 * nb, 64 * kb, 32 * nb, scr, lane); } }
        { bf16* W2T = (bf16*)(ws + WS_SMALL); bf16* A2T = W2T + 1024 * 64; bf16* G2T = A2T + 1024 * 64;
          for (int it = gw; it < 128; it += NGW) { const int nb = it & 31, wsel = it >> 5;
              if (wsel == 0) transpose_item(args.in[6], 1024, W2T, 64, 32 * nb, 0, 32 * nb, scr, lane);
              else if (wsel == 1) transpose_item(args.in[8], 1024, A2T, 64, 32 * nb, 0, 32 * nb, scr, lane);
              else transpose_item(args.in[9], 1024, G2T, 128, 32 * nb, 64 * (wsel - 2), 32 * nb, scr, lane); } }
        const float* n1w = args.in[2];
        for (int m = gw; m < MPAD; m += NGW) {
            if (m < MX) rms_row_to_bf16(x + (size_t)m * D, n1w, KP_U + (size_t)m * D, lane);
            else if (m < MROWS) rms_row_to_bf16(args.in[1] + (size_t)(m - MX) * D, n1w, KP_U + (size_t)m * D, lane);
            else { GAS unsigned long long* o8 = (GAS unsigned long long*)(KP_U + (size_t)m * D) + lane;
#pragma unroll
                for (int j = 0; j < 4; ++j) o8[64 * j] = 0ull; }
        }
    }
    xcd_barrier(bar); STAMP();
    }
    for (int rep_ = 0; rep_ < NREP(1); ++rep_) {
    {
        pg8::Gemm g{KP_U, KP_WinT, MPAD, IN_COLS, D}; pg8::InProjOrder S; S.init(G, bx);
        pg8::EpiInProj E{KP_PR, KP_PD, KP_PG, args.in[15], args.in[16], (const float*)(ws + WS_SMALL + 768 * 1024)};
        pg8::gemm_phase<pg8::EpiInProj, pg8::InProjOrder, true, true>(lds, g, S, E);
    }
    xcd_barrier(bar); STAMP();
    }
    if (REP_PHASE == 9) { for (int r9 = 0; r9 < 10; ++r9) xcd_barrier(bar); }
    for (int rep_ = 0; rep_ < NREP(2); ++rep_) {
    {
        if (vcu < 128) {
            rk::Params RP{KP_PR, KP_RO, args.in[4], args.in[5], args.in[7], args.in[10], args.in[11], args.in[12], args.in[13], args.in[14], (const bf16*)(ws + WS_SMALL), (const bf16*)(ws + WS_SMALL) + 1024 * 64, (const bf16*)(ws + WS_SMALL) + 2 * 1024 * 64};
            rk::run(lds, RP, vcu >> 4, vcu & 15);
            if (REP_PHASE == 20) rk::run(lds, RP, vcu >> 4, vcu & 15);
#if defined(PROBE_A)
            if (vcu == 0 && tid == 0) tsw[30] = __builtin_amdgcn_s_memrealtime();
#endif
        }
        float lam;
        { const float a1 = args.in[17][lane] * args.in[18][lane], a2 = args.in[19][lane] * args.in[20][lane]; lam = expf(wave_sum(a1)) - expf(wave_sum(a2)) + 0.2f; }
        for (;;) {
            if (tid == 0) MISC[0] = __hip_atomic_fetch_add(ctl + CW_QUEUE + 64 * rep_, 1u, RLX_AGENT);
            __syncthreads();
            const int idx = (int)MISC[0];
            __syncthreads();
            if (idx >= 1024) break;
            const int qb = 15 - (idx >> 6), bh = idx & 63;
            att::unit(lds, KP_PD, KP_DO, bh >> 3, bh & 7, qb, lam, args.in[21]);
        }
    }
    xcd_barrier(bar); STAMP();
    }
    if (REP_PHASE == 21) {
        float lam;
        { const float a1 = args.in[17][lane] * args.in[18][lane], a2 = args.in[19][lane] * args.in[20][lane]; lam = expf(wave_sum(a1)) - expf(wave_sum(a2)) + 0.2f; }
        for (;;) {
            if (tid == 0) MISC[0] = __hip_atomic_fetch_add(ctl + CW_QUEUE + 128, 1u, RLX_AGENT);
            __syncthreads();
            const int idx = (int)MISC[0];
            __syncthreads();
            if (idx >= 1024) break;
            const int qb = 15 - (idx >> 6), bh = idx & 63;
            att::unit(lds, KP_PD, KP_DO, bh >> 3, bh & 7, qb, lam, args.in[21]);
        }
        xcd_barrier(bar);
    }
    {
        pg8::Gemm g{KP_RO, (const bf16*)(ws + WS_WBR), 2 * MX, 2 * D, D}; pg8::BranchOrder S; S.so.init(MX, D, G, bx);
        pg8::EpiBranch E{KP_PG, KP_HID, KP_MRG};
        pg8::gemm_phase<pg8::EpiBranch, pg8::BranchOrder, true, true>(lds, g, S, E);
    }
    xcd_barrier(bar); STAMP();
    for (int rep_ = 0; rep_ < NREP(4); ++rep_) {
    {
        pg8::Gemm g{KP_MRG, (const bf16*)(ws + WS_WOUT), MX, D, D}; pg8::StaticOrder S; S.init(MX, D, G, bx);
        pg8::EpiResF32 E{x, out};
        pg8::gemm_phase<pg8::EpiResF32, pg8::StaticOrder, true, true>(lds, g, S, E);
    }
    xcd_barrier(bar); STAMP();
    }
    {
        LAS unsigned* hist = (LAS unsigned*)(lds + 131072);
        if (tid < 32) hist[tid] = 0u;
        __syncthreads();
        for (int i = bx * NTHREADS + tid; i < MOE_CAP; i += G * NTHREADS) KP_tokk[i] = -1;
        if (bx == 0) ((GAS unsigned*)(KP_XN2 + (size_t)MX * D))[tid] = 0u;
        LAS float* scr = (LAS float*)(lds + wave * 16384);
        for (int rp5 = 0; rp5 < NREP(5); ++rp5) { if (rp5) hist += 64;
            for (int w4 = gw; w4 < MX / 4; w4 += NGW) moe_row4(out, args.in[25], KP_XN2, args.in[26], args.in[27], args.in[28], args.in[29], KP_te, KP_tg, 4 * w4, hist, lane);
            LAS float* scr = (LAS float*)(lds + wave * 16384);
            for (int it = gw; it < 24576; it += NGW) {
                if (it < 16384) { const int up = it >> 13, r = it & 8191, e = r >> 8, q = r & 255, kb = q >> 4, nb = q & 15, n0 = 32 * nb;
                    transpose_item(args.in[30 + up] + (size_t)e * 524288, 512, KP_WGU, 1024, e * 1024 + (n0 >> 7) * 256 + up * 128 + (n0 & 127), 64 * kb, n0, scr, lane); }
                else { const int r = it - 16384, e = r >> 8, q = r & 255, kb = q >> 5, nb = q & 31;
                    transpose_item(args.in[32] + (size_t)e * 524288, 1024, KP_WDN, 512, e * 1024 + 32 * nb, 64 * kb, 32 * nb, scr, lane); }
            }
        }
        __syncthreads();
        if (NREP(5) == 2) hist -= 64;
        if (tid < 32) __hip_atomic_fetch_add(ctl + RW_CNT + 64 * tid, hist[tid], RLX_AGENT);
    }
    xcd_barrier(bar); STAMP();
    {
        LAS unsigned* st = (LAS unsigned*)(lds + 131072);
        if (tid < 64) {
            const unsigned cn = (lane < NEXP) ? __hip_atomic_load(ctl + RW_CNT + 64 * (lane & 31), RLX_AGENT) : 0u;
            const unsigned ntl = (cn + 255u) >> 8; unsigned inc = ntl;
#pragma unroll
            for (int o = 1; o < 32; o <<= 1) { const unsigned t = __shfl_up(inc, o); if ((lane & 31) >= o) inc += t; }
            const unsigned start_t = inc - ntl;
            if (lane < NEXP) { st[lane] = start_t << 8;
                if (bx == 0) { for (unsigned j2 = 0; j2 < ntl; ++j2) __hip_atomic_store(ctl + RW_TE + start_t + j2, (unsigned)lane, RLX_AGENT); if (lane == NEXP - 1) __hip_atomic_store(ctl + RW_NT, inc, RLX_AGENT); } }
        }
        __syncthreads();
        if (lane < 16) { const int m = gw + NGW * (lane >> 1), a = lane & 1;
            if (m < MX) { const int e = KP_te[2 * m + a]; const unsigned pos = __hip_atomic_fetch_add(ctl + RW_CUR + 64 * e, 1u, RLX_AGENT); const unsigned slot = st[e] + pos;
                KP_tokk[slot] = 2 * m + a; KP_rgate[slot] = KP_tg[2 * m + a]; } }
    }
    xcd_barrier(bar); STAMP();
    const int ntile = (int)__hip_atomic_load(ctl + RW_NT, RLX_AGENT);
    for (int rep_ = 0; rep_ < NREP(6); ++rep_) {
    {
        pg8::Gemm g{KP_XN2, KP_WGU, 0, 0, D}; pg8::MoeOrder S{KP_tokk, (const unsigned*)(ws + WS_CTL) + RW_TE, ntile, G, vcu, true, 2048u};
        pg8::EpiSwiGLU E{KP_HID};
        pg8::gemm_phase_g<pg8::EpiSwiGLU, pg8::MoeOrder>(lds, g, S, E);
    }
    xcd_barrier(bar); STAMP();
    }
    {
        pg8::Gemm g{KP_HID, KP_WDN, 0, 0, EFF}; pg8::MoeOrder S{KP_tokk, (const unsigned*)(ws + WS_CTL) + RW_TE, ntile, G, vcu, false, 1024u};
        pg8::EpiMoeDown E{KP_tokk, KP_rgate, out, KP_Y1};
        pg8::gemm_phase_g<pg8::EpiMoeDown, pg8::MoeOrder>(lds, g, S, E);
    }
    xcd_barrier(bar); STAMP();
    {
        int tid5 = threadIdx.x; asm volatile("" : "+v"(tid5)); const int lane = tid5 & 63; const int gw = vcu * NWAVES + __builtin_amdgcn_readfirstlane(tid5 >> 6);
        for (int m0 = gw; m0 < MX; m0 += 2 * NGW) {
            const int m1 = m0 + NGW; const bool h1 = m1 < MX; const int m1c = h1 ? m1 : m0;
            GAS f32x4* oa = (GAS f32x4*)(out + (size_t)m0 * D) + lane; const GAS v2u* ya = (const GAS v2u*)(KP_Y1 + (size_t)m0 * D) + lane;
            GAS f32x4* ob = (GAS f32x4*)(out + (size_t)m1c * D) + lane; const GAS v2u* yb = (const GAS v2u*)(KP_Y1 + (size_t)m1c * D) + lane;
            f32x4 va[4], vb[4]; v2u wa[4], wb[4];
#pragma unroll
            for (int j = 0; j < 4; ++j) { va[j] = oa[64 * j]; wa[j] = ya[64 * j]; vb[j] = ob[64 * j]; wb[j] = yb[64 * j]; }
#pragma unroll
            for (int j = 0; j < 4; ++j) { f32x4 v = va[j]; v.x += bflo(wa[j].x); v.y += bfhi(wa[j].x); v.z += bflo(wa[j].y); v.w += bfhi(wa[j].y);
#if defined(PROBE_A)
                if (m0 == 0 && lane == 0 && j == 0 && bx == 0) { v.x += (float)(long long)(tsw[PROBE_A1] - tsw[PROBE_A]) * 0.001f; }
#endif
                oa[64 * j] = v; }
            if (h1) {
#pragma unroll
                for (int j = 0; j < 4; ++j) { f32x4 v = vb[j]; v.x += bflo(wb[j].x); v.y += bfhi(wb[j].x); v.z += bflo(wb[j].y); v.w += bfhi(wb[j].y); ob[64 * j] = v; } }
        }
    }
#if defined(PROBE_A)
    if (bx == 0 && tid == 0) { const unsigned long long d = tsw[PROBE_B1] - tsw[PROBE_B]; const unsigned long long t0 = __builtin_amdgcn_s_memrealtime(); while (__builtin_amdgcn_s_memrealtime() - t0 < d) __builtin_amdgcn_s_sleep(8); }
#endif
}

extern "C" void kernel_launch(void* const* d_in, const int* in_sizes, int n_in, void* d_out, int out_size, void* d_ws, size_t ws_size, hipStream_t stream) {
    static int grid = 0;
    if (grid == 0) {
        if (n_in != 33 || out_size != MX * D || ws_size < WS_END) { fprintf(stderr, "kernel_launch: unexpected shapes n_in %d out %d ws %zu\n", n_in, out_size, ws_size); grid = -1; return; }
        int dev = 0, cus = 0;
        if (hipGetDevice(&dev) != hipSuccess || hipDeviceGetAttribute(&cus, hipDeviceAttributeMultiprocessorCount, dev) != hipSuccess) { grid = -1; return; }
        if (hipFuncSetAttribute((const void*)fwd_kernel, hipFuncAttributeMaxDynamicSharedMemorySize, LDS_BYTES) != hipSuccess) { fprintf(stderr, "kernel_launch: hipFuncSetAttribute failed\n"); grid = -1; return; }
        int per_cu = 0;
        if (hipOccupancyMaxActiveBlocksPerMultiprocessor(&per_cu, (const void*)fwd_kernel, NTHREADS, LDS_BYTES) != hipSuccess || per_cu < 1) fprintf(stderr, "kernel_launch: occupancy query says %d\n", per_cu);
        (void)hipGetLastError();
        grid = cus;
    }
    if (grid < 0) return;
    (void)hipMemsetAsync((char*)d_ws + WS_CTL, 0, CTL_ZERO_BYTES, stream);
    Args a{};
    for (int i = 0; i < 33; ++i) a.in[i] = (const float*)d_in[i];
    a.out = (float*)d_out; a.ws = (unsigned char*)d_ws;
    hipLaunchKernelGGL(fwd_kernel, dim3(grid), dim3(NTHREADS), LDS_BYTES, stream, a);
}
```
